# Optimizing an MI355X kernel written in HIP

```python
import functools
import jax, jax.numpy as jnp
from jax import lax
import numpy as np

D_MODEL = 2048
BATCH = 1
SEQ = 16384
DEPTH = 1
DEC_BATCH = 128
DEC_SEQ = 1
PAST_LEN = 16384
PAGE_SIZE = 128

N_META = 16
LRU_WIDTH = 1024
N_LRU_BLOCKS = 8
LRU_BLOCK = LRU_WIDTH // N_LRU_BLOCKS
CONV_W = 4
LRU_C = 8.0
N_HEADS = 16
N_KV_HEADS = 4
HEAD_DIM = 64
GROUP = N_HEADS // N_KV_HEADS
ATTN_WIDTH = N_HEADS * HEAD_DIM
KV_WIDTH = N_KV_HEADS * HEAD_DIM
WINDOW = 128
BLOCK = 128
D_FF = 4 * D_MODEL
EPS = 1e-6
NEG_INF = -1e30
SPLIT_IDX = (LRU_WIDTH, 2 * LRU_WIDTH, 2 * LRU_WIDTH + ATTN_WIDTH, 2 * LRU_WIDTH + ATTN_WIDTH + KV_WIDTH, 2 * LRU_WIDTH + ATTN_WIDTH + 2 * KV_WIDTH, 2 * LRU_WIDTH + ATTN_WIDTH + 2 * KV_WIDTH + D_MODEL)
IN_WIDTH = SPLIT_IDX[-1] + D_MODEL

kernel_name = "griffin_swa_sink_alibi_meta_decode_step"


def rms_norm(x, g):
    xf = x.astype(jnp.float32)
    y = xf * lax.rsqrt(jnp.mean(xf * xf, axis=-1, keepdims=True) + EPS) * g.astype(jnp.float32)
    return y.astype(x.dtype)


def alibi_slopes():
    return 2.0 ** (-8.0 * jnp.arange(1, N_HEADS + 1, dtype=jnp.float32) / N_HEADS)


def sink_attention(q, k, v, dist, valid, sinks):
    qf = q.astype(jnp.float32) * (HEAD_DIM ** -0.5)
    s = jnp.einsum('...qhgd,...khd->...hgqk', qf, k.astype(jnp.float32))
    slopes = alibi_slopes().reshape(N_KV_HEADS, GROUP, 1, 1)
    s = jnp.where(valid, s - slopes * dist, NEG_INF)
    sink = sinks.astype(jnp.float32).reshape(N_KV_HEADS, GROUP, 1, 1)
    m = jnp.maximum(jnp.max(s, axis=-1, keepdims=True), sink)
    e = jnp.exp(s - m)
    p = e / (jnp.sum(e, axis=-1, keepdims=True) + jnp.exp(sink - m))
    o = jnp.einsum('...hgqk,...khd->...qhgd', p, v.astype(jnp.float32))
    return o.astype(q.dtype)


def prompt_attention(q, k, v, sinks, cache_len):
    B, T = q.shape[0], q.shape[1]
    pad = (-T) % BLOCK
    Tp = T + pad
    nb = Tp // BLOCK
    qb = jnp.pad(q, ((0, 0), (pad, 0), (0, 0), (0, 0), (0, 0))).reshape(B, nb, BLOCK, N_KV_HEADS, GROUP, HEAD_DIM)

    def band(a):
        ext = jnp.pad(a, ((0, 0), (pad + BLOCK, 0), (0, 0), (0, 0)))
        prev = ext[:, :Tp].reshape(B, nb, BLOCK, N_KV_HEADS, HEAD_DIM)
        cur = ext[:, BLOCK:].reshape(B, nb, BLOCK, N_KV_HEADS, HEAD_DIM)
        meta = jnp.broadcast_to(a[:, None, :N_META], (B, nb, N_META, N_KV_HEADS, HEAD_DIM))
        return jnp.concatenate([meta, prev, cur], axis=2)

    kb, vb = band(k), band(v)
    r = jnp.arange(BLOCK)[:, None]
    c = jnp.arange(2 * BLOCK)[None, :]
    blk = jnp.arange(nb)[:, None, None]
    q_pos = blk * BLOCK + r[None] - pad
    k_pos = (blk - 1) * BLOCK + c[None] - pad
    d = q_pos - k_pos
    band_valid = (d >= 0) & (d <= WINDOW) & (k_pos >= N_META)
    meta_valid = q_pos >= jnp.arange(N_META)
    valid = jnp.concatenate([meta_valid, band_valid], axis=-1)[:, None, None]
    dist = jnp.concatenate([jnp.zeros((BLOCK, N_META), jnp.int32), r + BLOCK - c], axis=-1).astype(jnp.float32)
    o = sink_attention(qb, kb, vb, dist, valid, sinks)
    o = o.reshape(B, Tp, ATTN_WIDTH)[:, pad:]
    return o, (k[:, :N_META], v[:, :N_META], k[:, T - cache_len:], v[:, T - cache_len:])


def sample_attention(q, k, v, meta_k, meta_v, win_k, win_v, sinks):
    B, S = q.shape[0], q.shape[1]
    Lb = win_k.shape[1]
    kw = jnp.concatenate([win_k.astype(k.dtype), k], axis=1)
    vw = jnp.concatenate([win_v.astype(v.dtype), v], axis=1)
    kc = jnp.concatenate([meta_k.astype(k.dtype), kw], axis=1)
    vc = jnp.concatenate([meta_v.astype(v.dtype), vw], axis=1)
    i = jnp.arange(S)[:, None]
    j = jnp.arange(Lb + S)[None, :]
    d = i + Lb - j
    k_pos = PAST_LEN - Lb + j
    band_valid = (d >= 0) & (d <= WINDOW) & (k_pos >= N_META)
    valid = jnp.concatenate([jnp.ones((S, N_META), bool), band_valid], axis=-1)
    dist = jnp.concatenate([jnp.zeros((S, N_META), jnp.int32), d], axis=-1).astype(jnp.float32)
    o = sink_attention(q, kc, vc, dist, valid, sinks).reshape(B, S, ATTN_WIDTH)
    return o, (kw[:, -Lb:], vw[:, -Lb:])


def causal_conv(x_ext, w, b):
    L = x_ext.shape[1] - (CONV_W - 1)
    y = x_ext[:, 0:L] * w[0]
    for t in range(1, CONV_W):
        y = y + x_ext[:, t:t + L] * w[t]
    return y + b


def block_diag(x, w, b):
    B, L = x.shape[0], x.shape[1]
    y = jnp.einsum('blni,nij->blnj', x.reshape(B, L, N_LRU_BLOCKS, LRU_BLOCK), w)
    return y.reshape(B, L, LRU_WIDTH) + b


def rg_lru(xc, h0, w_gx, b_gx, w_ga, b_ga, a_param):
    gate_x = jax.nn.sigmoid(block_diag(xc, w_gx, b_gx)).astype(jnp.float32)
    gate_a = jax.nn.sigmoid(block_diag(xc, w_ga, b_ga)).astype(jnp.float32)
    log_a = -LRU_C * gate_a * jax.nn.softplus(-a_param.astype(jnp.float32))
    a = jnp.exp(log_a)
    b = jnp.sqrt(-jnp.expm1(2.0 * log_a)) * gate_x * xc.astype(jnp.float32)

    def step(h, ab):
        a_t, b_t = ab
        h = a_t * h + b_t
        return h, h

    h_last, hs = lax.scan(step, h0.astype(jnp.float32), (jnp.swapaxes(a, 0, 1), jnp.swapaxes(b, 0, 1)))
    return jnp.swapaxes(hs, 0, 1).astype(xc.dtype), h_last.astype(h0.dtype)


def trunk_layer(x, conv_prev, h0, attend, norm1_g, w_in, conv_w, conv_b, w_gate_x, b_gate_x, w_gate_a, b_gate_a,
                lru_a_param, w_lru_out, w_attn_out, w_o, norm2_g, w_mlp_up, w_mlp_down):
    B, L = x.shape[0], x.shape[1]
    xn = rms_norm(x, norm1_g)
    proj = xn @ w_in
    xb, yb, q, k, v, g_lru, g_attn = jnp.split(proj, SPLIT_IDX, axis=-1)
    x_ext = jnp.concatenate([conv_prev.astype(xb.dtype), xb], axis=1)
    xc = causal_conv(x_ext, conv_w, conv_b)
    hs, h_last = rg_lru(xc, h0, w_gate_x, b_gate_x, w_gate_a, b_gate_a, lru_a_param)
    lru_out = jax.nn.gelu(yb) * hs
    q = q.reshape(B, L, N_KV_HEADS, GROUP, HEAD_DIM)
    k = k.reshape(B, L, N_KV_HEADS, HEAD_DIM)
    v = v.reshape(B, L, N_KV_HEADS, HEAD_DIM)
    attn_out, attn_state = attend(q, k, v)
    merged = jax.nn.sigmoid(g_lru) * (lru_out @ w_lru_out) + jax.nn.sigmoid(g_attn) * (attn_out @ w_attn_out)
    h = x + merged @ w_o
    u = jnp.square(jax.nn.relu(rms_norm(h, norm2_g) @ w_mlp_up))
    out = h + u @ w_mlp_down
    return out, x_ext[:, -(CONV_W - 1):], h_last, attn_state


def setup_inputs(seed: int = 0) -> dict:
    key = jax.random.key(seed)
    ks = jax.random.split(key, 32)
    cw = min(WINDOW, PAST_LEN)

    def nrm(k, shape, scale):
        return jax.random.normal(k, shape, jnp.float32) * scale

    u = jax.random.uniform(ks[14], (DEPTH, LRU_WIDTH), jnp.float32, 0.9, 0.999)
    s = u ** (1.0 / LRU_C)
    lru_a_param = jnp.log(s) - jnp.log1p(-s)
    return {
        "x_prompt": nrm(ks[0], (BATCH, SEQ, D_MODEL), 1.0),
        "x_sample": nrm(ks[1], (DEC_BATCH, DEC_SEQ, D_MODEL), 1.0),
        "cache_meta_k": nrm(ks[2], (DEPTH, DEC_BATCH, N_META, N_KV_HEADS, HEAD_DIM), 1.0),
        "cache_meta_v": nrm(ks[3], (DEPTH, DEC_BATCH, N_META, N_KV_HEADS, HEAD_DIM), 1.0),
        "cache_win_k": nrm(ks[4], (DEPTH, DEC_BATCH, cw, N_KV_HEADS, HEAD_DIM), 1.0),
        "cache_win_v": nrm(ks[5], (DEPTH, DEC_BATCH, cw, N_KV_HEADS, HEAD_DIM), 1.0),
        "state_conv": nrm(ks[6], (DEPTH, DEC_BATCH, CONV_W - 1, LRU_WIDTH), 1.0),
        "state_h": nrm(ks[7], (DEPTH, DEC_BATCH, LRU_WIDTH), 0.5),
        "meta_tokens": nrm(ks[8], (N_META, D_MODEL), 1.0),
        "norm1_g": 1.0 + nrm(ks[9], (DEPTH, D_MODEL), 0.02),
        "w_in": nrm(ks[10], (DEPTH, D_MODEL, IN_WIDTH), D_MODEL ** -0.5),
        "conv_w": nrm(ks[11], (DEPTH, CONV_W, LRU_WIDTH), CONV_W ** -0.5),
        "conv_b": nrm(ks[12], (DEPTH, LRU_WIDTH), 0.02),
        "w_gate_x": nrm(ks[13], (DEPTH, N_LRU_BLOCKS, LRU_BLOCK, LRU_BLOCK), LRU_BLOCK ** -0.5),
        "b_gate_x": nrm(ks[15], (DEPTH, LRU_WIDTH), 0.02),
        "w_gate_a": nrm(ks[16], (DEPTH, N_LRU_BLOCKS, LRU_BLOCK, LRU_BLOCK), LRU_BLOCK ** -0.5),
        "b_gate_a": nrm(ks[17], (DEPTH, LRU_WIDTH), 0.02),
        "lru_a_param": lru_a_param,
        "attn_sinks": nrm(ks[18], (DEPTH, N_HEADS), 0.5),
        "w_lru_out": nrm(ks[19], (DEPTH, LRU_WIDTH, D_MODEL), LRU_WIDTH ** -0.5),
        "w_attn_out": nrm(ks[20], (DEPTH, ATTN_WIDTH, D_MODEL), ATTN_WIDTH ** -0.5),
        "w_o": nrm(ks[21], (DEPTH, D_MODEL, D_MODEL), D_MODEL ** -0.5),
        "norm2_g": 1.0 + nrm(ks[22], (DEPTH, D_MODEL), 0.02),
        "w_mlp_up": nrm(ks[23], (DEPTH, D_MODEL, D_FF), D_MODEL ** -0.5),
        "w_mlp_down": nrm(ks[24], (DEPTH, D_FF, D_MODEL), D_FF ** -0.5),
        "final_norm_g": 1.0 + nrm(ks[25], (D_MODEL,), 0.02),
    }


def reference(x_prompt, x_sample, cache_meta_k, cache_meta_v, cache_win_k, cache_win_v, state_conv, state_h,
              meta_tokens, norm1_g, w_in, conv_w, conv_b, w_gate_x, b_gate_x, w_gate_a, b_gate_a, lru_a_param,
              attn_sinks, w_lru_out, w_attn_out, w_o, norm2_g, w_mlp_up, w_mlp_down, final_norm_g):
    B = x_prompt.shape[0]
    cw = min(WINDOW, PAST_LEN)
    xp = jnp.concatenate([jnp.broadcast_to(meta_tokens.astype(x_prompt.dtype)[None], (B, N_META, D_MODEL)), x_prompt], axis=1)
    xs = x_sample
    p_mk, p_mv, p_wk, p_wv, p_conv, p_h = [], [], [], [], [], []
    s_wk, s_wv, s_conv, s_h = [], [], [], []
    for l in range(DEPTH):
        lp = (norm1_g[l], w_in[l], conv_w[l], conv_b[l], w_gate_x[l], b_gate_x[l], w_gate_a[l], b_gate_a[l],
              lru_a_param[l], w_lru_out[l], w_attn_out[l], w_o[l], norm2_g[l], w_mlp_up[l], w_mlp_down[l])
        attend_p = functools.partial(prompt_attention, sinks=attn_sinks[l], cache_len=cw)
        conv0 = jnp.zeros((B, CONV_W - 1, LRU_WIDTH), xp.dtype)
        h0 = jnp.zeros((B, LRU_WIDTH), state_h.dtype)
        xp, conv_p, h_p, (mk, mv, wk, wv) = trunk_layer(xp, conv0, h0, attend_p, *lp)
        p_mk.append(mk)
        p_mv.append(mv)
        p_wk.append(wk)
        p_wv.append(wv)
        p_conv.append(conv_p)
        p_h.append(h_p)
        attend_s = functools.partial(sample_attention, meta_k=cache_meta_k[l], meta_v=cache_meta_v[l],
                                     win_k=cache_win_k[l], win_v=cache_win_v[l], sinks=attn_sinks[l])
        xs, conv_s, h_s, (wk_s, wv_s) = trunk_layer(xs, state_conv[l], state_h[l], attend_s, *lp)
        s_wk.append(wk_s)
        s_wv.append(wv_s)
        s_conv.append(conv_s)
        s_h.append(h_s)
    y_prompt = rms_norm(xp, final_norm_g)[:, N_META:]
    y_sample = rms_norm(xs, final_norm_g)
    return (y_prompt, y_sample, jnp.stack(p_mk), jnp.stack(p_mv), jnp.stack(p_wk), jnp.stack(p_wv), jnp.stack(p_conv), jnp.stack(p_h), jnp.stack(s_wk), jnp.stack(s_wv), jnp.stack(s_conv), jnp.stack(s_h))
```

```cpp
#include <hip/hip_runtime.h>
#include <hip/hip_cooperative_groups.h>
#include <cstdio>
#include <cstdint>
namespace cg = cooperative_groups;

#ifndef MK_N_LAUNCHES
#define MK_N_LAUNCHES 9
#endif
constexpr int N_PHASES = 9;

namespace pg8 {
#define PG8_LAS __attribute__((address_space(3)))
typedef unsigned short bf16_t;
typedef short bf16x8 __attribute__((ext_vector_type(8)));
typedef float f32x4 __attribute__((ext_vector_type(4)));
typedef unsigned u32x4 __attribute__((ext_vector_type(4)));
constexpr int BM = 256, BK = 64, HALF = 128, HTB = HALF * BK * 2, STAGE_BYTES = 8 * HTB, NXCD = 8, WGM = 8;

__host__ __device__ __forceinline__ int lds_byte(int r, int c) { const int st = (r >> 4) * 2 + (c >> 5), rr = r & 15, cc = c & 31, ob = rr * 64 + cc * 2; return st * 1024 + (ob ^ (((ob >> 9) & 1) << 5)); }
__host__ __device__ __forceinline__ void stage_rc(int b, int& R, int& C) { const int st = b / 1024, sb = b % 1024, swz = sb ^ (((sb >> 9) & 1) << 5); R = (st >> 1) * 16 + swz / 64; C = (st & 1) * 32 + (swz % 64) / 2; }
__host__ __device__ __forceinline__ int perm32(int rho) { const int n = rho >> 4, i = rho & 15; return 8 * (i >> 2) + 4 * n + (i & 3); }

struct Unit { int pm, pn; };
struct Gemm { const bf16_t* A; const bf16_t* Bt; int M, N, K; };

struct StaticOrder {
    int nM, nN, nwg, G, c;
    __host__ __device__ void init(int M, int N, int G_, int c_) { nM = M / BM; nN = N / BM; nwg = nM * nN; G = G_; c = c_; }
    __host__ __device__ bool next(int i, Unit& u) const {
        const long L = (long)i * G + c; if (L >= nwg) return false;
        int wgid = (int)L; { const int q = nwg / NXCD, r = nwg % NXCD, xcd = wgid % NXCD, off = wgid / NXCD; wgid = (xcd < r ? xcd * (q + 1) : r * (q + 1) + (xcd - r) * q) + off; }
        const int nig = WGM * nN, gid = wgid / nig, fm = gid * WGM, gsz = (nM - fm) < WGM ? (nM - fm) : WGM;
        u.pm = fm + ((wgid % nig) % gsz); u.pn = (wgid % nig) / gsz; return true;
    }
    __device__ __forceinline__ void a_ready(const Unit&) const {}
    __device__ __forceinline__ void done(const Unit&) const {}
};

typedef float f32x2_t __attribute__((ext_vector_type(2))); typedef __bf16 bf16x2_t __attribute__((ext_vector_type(2)));
__device__ __forceinline__ unsigned cvt_pk_bf16(float lo, float hi) { f32x2_t v = {lo, hi}; bf16x2_t b = __builtin_convertvector(v, bf16x2_t); return __builtin_bit_cast(unsigned, b); }
__device__ __forceinline__ float bf_lo(unsigned w) { return __uint_as_float(w << 16); }
__device__ __forceinline__ float bf_hi(unsigned w) { return __uint_as_float(w & 0xffff0000u); }
__device__ __forceinline__ float sigmoidf_(float x) { return __builtin_amdgcn_rcpf(1.0f + __builtin_amdgcn_exp2f(-1.4426950408889634f * x)); }

struct EpiBf16 {
    static constexpr bool PERM = true;
    bf16_t* O; int ldc;
    __device__ __forceinline__ void operator()(const f32x4 (&acc)[2][2][4][2], const Unit& u, int wr, int wc, int fr, int fq) const {
        const int row0 = u.pm * BM + wr * 64 + fr; const int col0 = u.pn * BM + wc * 32 + 8 * fq;
#pragma unroll
        for (int ai = 0; ai < 2; ++ai)
#pragma unroll
            for (int m = 0; m < 4; ++m) { bf16_t* rowp = O + (size_t)(row0 + ai * HALF + m * 16) * ldc + col0;
#pragma unroll
                for (int bj = 0; bj < 2; ++bj) { const f32x4 v0 = acc[ai][bj][m][0], v1 = acc[ai][bj][m][1];
                    u32x4 w; w.x = cvt_pk_bf16(v0[0], v0[1]); w.y = cvt_pk_bf16(v0[2], v0[3]); w.z = cvt_pk_bf16(v1[0], v1[1]); w.w = cvt_pk_bf16(v1[2], v1[3]);
                    *(u32x4*)(rowp + bj * HALF) = w; } }
    }
};
struct BigBuf { float* main; float* tail;
    __device__ __forceinline__ float* tile(int pm) const { return pm < 64 ? main + (size_t)pm * 256 * 2048 : tail; } };
struct BigBufC { const float* main; const float* tail;
    __device__ __forceinline__ const float* tile(int pm) const { return pm < 64 ? main + (size_t)pm * 256 * 2048 : tail; } };

struct EpiGateF32 {
    static constexpr bool PERM = true;
    BigBuf T; const bf16_t* gate; int gld;
    __device__ __forceinline__ void operator()(const f32x4 (&acc)[2][2][4][2], const Unit& u, int wr, int wc, int fr, int fq) const {
        const int rl0 = wr * 64 + fr; const int col0 = u.pn * BM + wc * 32 + 8 * fq; float* tb = T.tile(u.pm);
#pragma unroll
        for (int ai = 0; ai < 2; ++ai)
#pragma unroll
            for (int m = 0; m < 4; ++m) { const int rl = rl0 + ai * HALF + m * 16; const bf16_t* gp = gate + (size_t)(u.pm * BM + rl) * gld + col0; float* tp = tb + (size_t)rl * 2048 + col0;
#pragma unroll
                for (int bj = 0; bj < 2; ++bj) { const u32x4 g = *(const u32x4*)(gp + bj * HALF); const f32x4 v0 = acc[ai][bj][m][0], v1 = acc[ai][bj][m][1];
                    f32x4 o0, o1;
                    o0[0] = sigmoidf_(bf_lo(g.x)) * v0[0]; o0[1] = sigmoidf_(bf_hi(g.x)) * v0[1]; o0[2] = sigmoidf_(bf_lo(g.y)) * v0[2]; o0[3] = sigmoidf_(bf_hi(g.y)) * v0[3];
                    o1[0] = sigmoidf_(bf_lo(g.z)) * v1[0]; o1[1] = sigmoidf_(bf_hi(g.z)) * v1[1]; o1[2] = sigmoidf_(bf_lo(g.w)) * v1[2]; o1[3] = sigmoidf_(bf_hi(g.w)) * v1[3];
                    *(f32x4*)(tp + bj * HALF) = o0; *(f32x4*)(tp + bj * HALF + 4) = o1; }
                if (m & 1) asm volatile("" ::: "memory"); }
    }
};
struct EpiMerge {
    static constexpr bool PERM = true;
    BigBufC T; const bf16_t* gate; int gld; bf16_t* O;
    __device__ __forceinline__ void operator()(const f32x4 (&acc)[2][2][4][2], const Unit& u, int wr, int wc, int fr, int fq) const {
        const int rl0 = wr * 64 + fr; const int col0 = u.pn * BM + wc * 32 + 8 * fq; const float* tb = T.tile(u.pm);
#pragma unroll
        for (int ai = 0; ai < 2; ++ai)
#pragma unroll
            for (int m = 0; m < 4; ++m) { const int rl = rl0 + ai * HALF + m * 16; const size_t grow = (size_t)(u.pm * BM + rl);
                const bf16_t* gp = gate + grow * gld + col0; const float* tp = tb + (size_t)rl * 2048 + col0; bf16_t* op = O + grow * 2048 + col0;
#pragma unroll
                for (int bj = 0; bj < 2; ++bj) { const u32x4 g = *(const u32x4*)(gp + bj * HALF); const f32x4 t0 = *(const f32x4*)(tp + bj * HALF), t1 = *(const f32x4*)(tp + bj * HALF + 4);
                    const f32x4 v0 = acc[ai][bj][m][0], v1 = acc[ai][bj][m][1];
                    f32x4 o0, o1;
                    o0[0] = sigmoidf_(bf_lo(g.x)) * v0[0] + t0[0]; o0[1] = sigmoidf_(bf_hi(g.x)) * v0[1] + t0[1]; o0[2] = sigmoidf_(bf_lo(g.y)) * v0[2] + t0[2]; o0[3] = sigmoidf_(bf_hi(g.y)) * v0[3] + t0[3];
                    o1[0] = sigmoidf_(bf_lo(g.z)) * v1[0] + t1[0]; o1[1] = sigmoidf_(bf_hi(g.z)) * v1[1] + t1[1]; o1[2] = sigmoidf_(bf_lo(g.w)) * v1[2] + t1[2]; o1[3] = sigmoidf_(bf_hi(g.w)) * v1[3] + t1[3];
                    u32x4 w; w.x = cvt_pk_bf16(o0[0], o0[1]); w.y = cvt_pk_bf16(o0[2], o0[3]); w.z = cvt_pk_bf16(o1[0], o1[1]); w.w = cvt_pk_bf16(o1[2], o1[3]);
                    *(u32x4*)(op + bj * HALF) = w; }
                if (m & 1) asm volatile("" ::: "memory"); }
    }
};
struct EpiResid {
    static constexpr bool PERM = true;
    BigBufC X; BigBuf Hh; bf16_t* HB; float* ss;
    __device__ __forceinline__ void operator()(const f32x4 (&acc)[2][2][4][2], const Unit& u, int wr, int wc, int fr, int fq) const {
        const int rl0 = wr * 64 + fr; const int col0 = u.pn * BM + wc * 32 + 8 * fq; const float* xb = X.tile(u.pm); float* hb_ = Hh.tile(u.pm);
#pragma unroll
        for (int ai = 0; ai < 2; ++ai)
#pragma unroll
            for (int m = 0; m < 4; ++m) { const int rl = rl0 + ai * HALF + m * 16; const size_t grow = (size_t)(u.pm * BM + rl);
                const float* xp = xb + (size_t)rl * 2048 + col0; float* hp = hb_ + (size_t)rl * 2048 + col0; bf16_t* op = HB + grow * 2048 + col0; float q = 0.f;
#pragma unroll
                for (int bj = 0; bj < 2; ++bj) { const f32x4 x0 = *(const f32x4*)(xp + bj * HALF), x1 = *(const f32x4*)(xp + bj * HALF + 4);
                    const f32x4 o0 = acc[ai][bj][m][0] + x0, o1 = acc[ai][bj][m][1] + x1;
                    q += (o0[0] * o0[0] + o0[1] * o0[1]) + (o0[2] * o0[2] + o0[3] * o0[3]) + (o1[0] * o1[0] + o1[1] * o1[1]) + (o1[2] * o1[2] + o1[3] * o1[3]);
                    *(f32x4*)(hp + bj * HALF) = o0; *(f32x4*)(hp + bj * HALF + 4) = o1;
                    u32x4 w; w.x = cvt_pk_bf16(o0[0], o0[1]); w.y = cvt_pk_bf16(o0[2], o0[3]); w.z = cvt_pk_bf16(o1[0], o1[1]); w.w = cvt_pk_bf16(o1[2], o1[3]);
                    *(u32x4*)(op + bj * HALF) = w; }
                q += __shfl_xor(q, 16); q += __shfl_xor(q, 32);
                if (fq == 0) atomicAdd(ss + grow, q);
                if (m & 1) asm volatile("" ::: "memory"); }
    }
};
struct EpiUp {
    static constexpr bool PERM = true;
    const float* ss; bf16_t* O;
    __device__ __forceinline__ void operator()(const f32x4 (&acc)[2][2][4][2], const Unit& u, int wr, int wc, int fr, int fq) const {
        const int row0 = u.pm * BM + wr * 64 + fr; const int col0 = u.pn * BM + wc * 32 + 8 * fq;
        float rs[2][4];
#pragma unroll
        for (int ai = 0; ai < 2; ++ai)
#pragma unroll
            for (int m = 0; m < 4; ++m) rs[ai][m] = __builtin_amdgcn_rsqf(ss[row0 + ai * HALF + m * 16] * (1.0f / 2048.0f) + 1e-6f);
#pragma unroll
        for (int ai = 0; ai < 2; ++ai)
#pragma unroll
            for (int m = 0; m < 4; ++m) { bf16_t* rowp = O + (size_t)(row0 + ai * HALF + m * 16) * 8192 + col0; const float r = rs[ai][m];
#pragma unroll
                for (int bj = 0; bj < 2; ++bj) { f32x4 v0 = acc[ai][bj][m][0] * r, v1 = acc[ai][bj][m][1] * r;
#pragma unroll
                    for (int j = 0; j < 4; ++j) { const float a = fmaxf(v0[j], 0.f), b = fmaxf(v1[j], 0.f); v0[j] = a * a; v1[j] = b * b; }
                    u32x4 w; w.x = cvt_pk_bf16(v0[0], v0[1]); w.y = cvt_pk_bf16(v0[2], v0[3]); w.z = cvt_pk_bf16(v1[0], v1[1]); w.w = cvt_pk_bf16(v1[2], v1[3]);
                    *(u32x4*)(rowp + bj * HALF) = w; } }
    }
};
struct EpiDown {
    static constexpr bool PERM = true;
    BigBuf Hh;
    __device__ __forceinline__ void operator()(const f32x4 (&acc)[2][2][4][2], const Unit& u, int wr, int wc, int fr, int fq) const {
        const int rl0 = wr * 64 + fr; const int col0 = u.pn * BM + wc * 32 + 8 * fq; float* hb_ = Hh.tile(u.pm);
#pragma unroll
        for (int ai = 0; ai < 2; ++ai)
#pragma unroll
            for (int m = 0; m < 4; ++m) { const int rl = rl0 + ai * HALF + m * 16; float* hp = hb_ + (size_t)rl * 2048 + col0;
#pragma unroll
                for (int bj = 0; bj < 2; ++bj) { const f32x4 x0 = *(const f32x4*)(hp + bj * HALF), x1 = *(const f32x4*)(hp + bj * HALF + 4);
                    *(f32x4*)(hp + bj * HALF) = acc[ai][bj][m][0] + x0; *(f32x4*)(hp + bj * HALF + 4) = acc[ai][bj][m][1] + x1; }
                if (m & 1) asm volatile("" ::: "memory"); }
    }
};

template <class Epi, class Sched, bool ALIGN_EPI = false, bool SP2 = false>
__device__ __forceinline__ void gemm_phase(PG8_LAS unsigned char* lds, const Gemm g, const Sched& S, const Epi& E) {
    const int tid = threadIdx.x, wid = __builtin_amdgcn_readfirstlane(tid >> 6), lane = tid & 63, wr = wid >> 2, wc = wid & 3, fr = lane & 15, fq = lane >> 4;
    const int K = g.K, nt = K / BK;
    unsigned voffA[2], voffB[2];
#pragma unroll
    for (int i = 0; i < 2; ++i) { int R, C; stage_rc(tid * 16 + i * 8192, R, C); const int Rb = Epi::PERM ? ((R & ~31) + perm32(R & 31)) : R;
        voffA[i] = (unsigned)(R * K + C) * 2u; voffB[i] = (unsigned)(Rb * K + C) * 2u; }
    const size_t kstep = (size_t)(BK * 2);
    const size_t hstep = (size_t)HALF * K * 2;
    const size_t tstep = 2 * hstep;
    const unsigned ldsw = (unsigned)wid * 1024u;
    const int aoff = lds_byte(wr * 64 + fr, fq * 8), boff = lds_byte(wc * 32 + fr, fq * 8);
#define PG8_SA(b, h) (((b) * 2 + (h)) * HTB)
#define PG8_SB(b, h) ((4 + (b) * 2 + (h)) * HTB)
#define PG8_STAGE(bufoff, gbase, voff) do { _Pragma("unroll") for (int _i = 0; _i < 2; ++_i) \
        __builtin_amdgcn_global_load_lds((const unsigned*)((const char*)(gbase) + (voff)[_i]), (PG8_LAS unsigned*)(lds + (bufoff) + ldsw + _i * 8192), 16, 0, 0); } while (0)
#define PG8_LDA(dst, b, h) do { _Pragma("unroll") for (int m = 0; m < 4; ++m) _Pragma("unroll") for (int k = 0; k < 2; ++k) dst[m][k] = *(const PG8_LAS bf16x8*)(lds + PG8_SA(b, h) + aoff + m * 2048 + k * 1024); } while (0)
#define PG8_LDB(dst, b, h) do { _Pragma("unroll") for (int n = 0; n < 2; ++n) _Pragma("unroll") for (int k = 0; k < 2; ++k) dst[n][k] = *(const PG8_LAS bf16x8*)(lds + PG8_SB(b, h) + boff + n * 2048 + k * 1024); } while (0)
#define PG8_MMA(ai, bj, At, Bt) do { __builtin_amdgcn_s_setprio(1); _Pragma("unroll") for (int m = 0; m < 4; ++m) _Pragma("unroll") for (int n = 0; n < 2; ++n) _Pragma("unroll") for (int k = 0; k < 2; ++k) \
        acc[ai][bj][m][n] = __builtin_amdgcn_mfma_f32_16x16x32_bf16(Bt[n][k], At[m][k], acc[ai][bj][m][n], 0, 0, 0); __builtin_amdgcn_s_setprio(0); } while (0)
#define PG8_WAIT_V(n) asm volatile("s_waitcnt vmcnt(" #n ")" ::: "memory")
#define PG8_WAIT_L(n) asm volatile("s_waitcnt lgkmcnt(" #n ")" ::: "memory")
#define PG8_BAR __builtin_amdgcn_s_barrier()
#define PG8_SCHED __builtin_amdgcn_sched_barrier(0)
    Unit cur, nxt; int ui = 0;
    if (!S.next(0, cur)) return;
    f32x4 acc[2][2][4][2];
#pragma unroll
    for (int a = 0; a < 2; ++a)
#pragma unroll
        for (int b = 0; b < 2; ++b)
#pragma unroll
            for (int m = 0; m < 4; ++m)
#pragma unroll
                for (int n = 0; n < 2; ++n) acc[a][b][m][n] = (f32x4){0.f, 0.f, 0.f, 0.f};
    bf16x8 At[4][2], B0[2][2], B1[2][2];
    const char* cA = (const char*)g.A + (size_t)cur.pm * tstep; const char* cB = (const char*)g.Bt + (size_t)cur.pn * tstep;
    S.a_ready(cur);
    if constexpr (SP2) {
        PG8_STAGE(PG8_SB(0, 0), cB, voffB); PG8_STAGE(PG8_SB(0, 1), cB + hstep, voffB); PG8_STAGE(PG8_SA(0, 0), cA, voffA); PG8_STAGE(PG8_SA(0, 1), cA + hstep, voffA);
        if (wr == 1) PG8_BAR;
        PG8_WAIT_V(2); PG8_BAR;
        PG8_STAGE(PG8_SB(1, 0), cB + kstep, voffB); PG8_STAGE(PG8_SA(1, 0), cA + kstep, voffA); PG8_STAGE(PG8_SB(1, 1), cB + hstep + kstep, voffB);
        PG8_WAIT_V(6); PG8_BAR;
    } else {
        PG8_STAGE(PG8_SB(0, 0), cB, voffB); PG8_STAGE(PG8_SA(0, 0), cA, voffA); PG8_STAGE(PG8_SB(0, 1), cB + hstep, voffB); PG8_STAGE(PG8_SA(0, 1), cA + hstep, voffA);
        if (wr == 1) PG8_BAR;
        PG8_WAIT_V(4); PG8_BAR;
        PG8_STAGE(PG8_SB(1, 0), cB + kstep, voffB); PG8_STAGE(PG8_SA(1, 0), cA + kstep, voffA); PG8_STAGE(PG8_SB(1, 1), cB + hstep + kstep, voffB);
        PG8_WAIT_V(6); PG8_BAR;
    }
    for (;;) {
        const bool has_next = S.next(ui + 1, nxt);
        const char* nA = has_next ? (const char*)g.A + (size_t)nxt.pm * tstep : cA; const char* nB = has_next ? (const char*)g.Bt + (size_t)nxt.pn * tstep : cB;
        for (int t = 0; t < nt; t += 2) {
            const bool last = (t == nt - 2);
            const char* a1 = cA + (size_t)(t + 1) * kstep;
            const char* a2 = last ? nA : cA + (size_t)(t + 2) * kstep; const char* b2 = last ? nB : cB + (size_t)(t + 2) * kstep;
            const char* a3 = a2 + kstep; const char* b3 = b2 + kstep;
            if (last && has_next) S.a_ready(nxt);
            if constexpr (SP2) {
            PG8_LDB(B0, 0, 0); PG8_LDB(B1, 0, 1); PG8_SCHED; PG8_LDA(At, 0, 0); PG8_STAGE(PG8_SA(1, 1), a1 + hstep, voffA);
            PG8_WAIT_V(8); PG8_WAIT_L(0); PG8_BAR; PG8_MMA(0, 0, At, B0); PG8_MMA(0, 1, At, B1); PG8_BAR; PG8_SCHED;
            PG8_LDA(At, 0, 1); PG8_STAGE(PG8_SB(0, 0), b2, voffB); PG8_STAGE(PG8_SB(0, 1), b2 + hstep, voffB); PG8_STAGE(PG8_SA(0, 0), a2, voffA);
            PG8_WAIT_V(8); PG8_WAIT_L(0); PG8_BAR; PG8_MMA(1, 0, At, B0); PG8_MMA(1, 1, At, B1); PG8_BAR; PG8_SCHED;
            PG8_LDB(B0, 1, 0); PG8_LDB(B1, 1, 1); PG8_SCHED; PG8_LDA(At, 1, 0); PG8_STAGE(PG8_SA(0, 1), a2 + hstep, voffA);
            PG8_WAIT_V(8); PG8_WAIT_L(0); PG8_BAR; PG8_MMA(0, 0, At, B0); PG8_MMA(0, 1, At, B1); PG8_BAR; PG8_SCHED;
            PG8_LDA(At, 1, 1); PG8_STAGE(PG8_SB(1, 0), b3, voffB); PG8_STAGE(PG8_SB(1, 1), b3 + hstep, voffB); PG8_STAGE(PG8_SA(1, 0), a3, voffA);
            PG8_WAIT_V(8); PG8_WAIT_L(0); PG8_BAR; PG8_MMA(1, 0, At, B0); PG8_MMA(1, 1, At, B1); PG8_BAR; PG8_SCHED;
            } else {
            PG8_LDB(B0, 0, 0); PG8_SCHED; PG8_LDA(At, 0, 0); PG8_STAGE(PG8_SA(1, 1), a1 + hstep, voffA);
            PG8_WAIT_L(8); PG8_BAR; PG8_WAIT_L(0); PG8_MMA(0, 0, At, B0); PG8_BAR; PG8_SCHED;
            PG8_LDB(B1, 0, 1); PG8_STAGE(PG8_SB(0, 0), b2, voffB);
            PG8_BAR; PG8_WAIT_L(0); PG8_MMA(0, 1, At, B1); PG8_BAR;
            PG8_LDA(At, 0, 1); PG8_STAGE(PG8_SA(0, 0), a2, voffA);
            PG8_BAR; PG8_WAIT_L(0); PG8_MMA(1, 0, At, B0); PG8_BAR; PG8_SCHED;
            PG8_STAGE(PG8_SB(0, 1), b2 + hstep, voffB);
            PG8_WAIT_V(6); PG8_BAR; PG8_MMA(1, 1, At, B1); PG8_BAR;
            PG8_LDB(B0, 1, 0); PG8_SCHED; PG8_LDA(At, 1, 0); PG8_STAGE(PG8_SA(0, 1), a2 + hstep, voffA);
            PG8_WAIT_L(8); PG8_BAR; PG8_WAIT_L(0); PG8_MMA(0, 0, At, B0); PG8_BAR; PG8_SCHED;
            PG8_LDB(B1, 1, 1); PG8_STAGE(PG8_SB(1, 0), b3, voffB);
            PG8_BAR; PG8_WAIT_L(0); PG8_MMA(0, 1, At, B1); PG8_BAR;
            PG8_LDA(At, 1, 1); PG8_STAGE(PG8_SA(1, 0), a3, voffA);
            PG8_BAR; PG8_WAIT_L(0); PG8_MMA(1, 0, At, B0); PG8_BAR; PG8_SCHED;
            PG8_STAGE(PG8_SB(1, 1), b3 + hstep, voffB);
            PG8_WAIT_V(6); PG8_BAR; PG8_MMA(1, 1, At, B1); PG8_BAR;
            }
        }
        if constexpr (ALIGN_EPI) { if (wr == 0) PG8_BAR; }
        E(acc, cur, wr, wc, fr, fq); S.done(cur);
        if (!has_next) break;
#pragma unroll
        for (int a = 0; a < 2; ++a)
#pragma unroll
            for (int b = 0; b < 2; ++b)
#pragma unroll
                for (int m = 0; m < 4; ++m)
#pragma unroll
                    for (int n = 0; n < 2; ++n) acc[a][b][m][n] = (f32x4){0.f, 0.f, 0.f, 0.f};
        cur = nxt; cA = nA; cB = nB; ++ui;
        if constexpr (ALIGN_EPI) { if (wr == 1) PG8_BAR; }
    }
    PG8_WAIT_V(0);
    if constexpr (!ALIGN_EPI) { if (wr == 0) PG8_BAR; }
    PG8_BAR;
#undef PG8_SA
#undef PG8_SB
#undef PG8_STAGE
#undef PG8_LDA
#undef PG8_LDB
#undef PG8_MMA
#undef PG8_WAIT_V
#undef PG8_WAIT_L
#undef PG8_BAR
#undef PG8_SCHED
}
}

typedef unsigned short bf16;
typedef float f32x4 __attribute__((ext_vector_type(4)));
typedef float f32x16 __attribute__((ext_vector_type(16)));
typedef short bf16x8 __attribute__((ext_vector_type(8)));
typedef unsigned u32x4 __attribute__((ext_vector_type(4)));
typedef unsigned u32x2 __attribute__((ext_vector_type(2)));
#define LAS __attribute__((address_space(3)))
#define DI __device__ __forceinline__

constexpr int DM = 2048, TX = 16384, NMETA = 16, NSAMP = 128, MROWS = 16640;
constexpr int ROW_META = 16384, ROW_SAMP = 16400, ROW_PAD = 16528;
constexpr int LRUW = 1024, INW = 7680, DFF = 8192, NWAVES = 8;
constexpr int C_XB = 0, C_YB = 1024, C_Q = 2048, C_K = 3072, C_V = 3328, C_GL = 3584, C_GA = 5632;
constexpr float RMS_EPS = 1e-6f, LOG2E = 1.4426950408889634f;
constexpr size_t O_Y = 0, O_YS = 33554432, O_MK = 33816576, O_MV = 33820672, O_WK = 33824768, O_WV = 33857536, O_CONV = 33890304, O_H = 33893376,
                 O_WKS = 33894400, O_WVS = 38088704, O_CONVS = 42283008, O_HS = 42676224, O_END = 42807296;
constexpr size_t MiB = 1u << 20;
constexpr size_t WS_WO = 1 * MiB, WS_WUP = 9 * MiB, WS_WDN = 41 * MiB, WS_WLRU = 73 * MiB, WS_WATT = 77 * MiB, WS_WG = 81 * MiB;
constexpr size_t WS_PROJ = 82 * MiB;
constexpr size_t WS_U = 82 * MiB;
constexpr size_t WS_B = 342 * MiB;
constexpr size_t WS_LRUO = WS_B, WS_ATTO = WS_B + (size_t)MROWS * 1024 * 2;
constexpr size_t WS_C = 407 * MiB;
constexpr size_t WS_WIN = WS_C, WS_VT = WS_C + 30 * MiB;
constexpr size_t WS_TAILF = 472 * MiB, WS_XTAIL = 474 * MiB, WS_AGG = 476 * MiB, WS_SS = 479 * MiB, WS_END = 480 * MiB;
constexpr int NCHUNK_SEQ = 257;
constexpr int LDS_BYTES = 147456;

struct Args { const float* in[26]; float* out; unsigned char* ws; int ph_lo, ph_hi; };

DI float bf2f(bf16 x) { return __uint_as_float((unsigned)x << 16); }
DI float bflo(unsigned w) { return __uint_as_float(w << 16); }
DI float bfhi(unsigned w) { return __uint_as_float(w & 0xffff0000u); }
DI unsigned pk2(float lo, float hi) { return pg8::cvt_pk_bf16(lo, hi); }
DI float wave_sum(float v) {
#pragma unroll
    for (int o = 1; o < 64; o <<= 1) v += __shfl_xor(v, o);
    return v;
}
DI float wave_max(float v) {
#pragma unroll
    for (int o = 1; o < 64; o <<= 1) v = fmaxf(v, __shfl_xor(v, o));
    return v;
}
DI float sigm(float x) { return __builtin_amdgcn_rcpf(1.0f + __builtin_amdgcn_exp2f(-LOG2E * x)); }
DI float gelu_tanh(float x) {
    const float y = 0.7978845608028654f * (x + 0.044715f * x * x * x);
    return x * sigm(2.0f * y);
}
DI float neg_expm1(float x) {
    if (x > -0.125f) { float p = 1.0f / 720.0f; p = p * x + 1.0f / 120.0f; p = p * x + 1.0f / 24.0f; p = p * x + 1.0f / 6.0f; p = p * x + 0.5f; p = p * x + 1.0f; return -(p * x); }
    return 1.0f - __builtin_amdgcn_exp2f(LOG2E * x);
}

DI void p0_transpose_item(const float* W, int K, int N, bf16* WT, int row_off, const float* kscale, LAS float* scr, int item, int lane) {
    const int nblk = N / 32, kb = item / nblk, nb = item % nblk, k0 = 64 * kb, n0 = 32 * nb;
#pragma unroll 8
    for (int i = 0; i < 32; ++i) { const int kk = 2 * i + (lane >> 5); float v = W[(size_t)(k0 + kk) * N + n0 + (lane & 31)]; if (kscale) v *= kscale[k0 + kk]; scr[kk * 33 + (lane & 31)] = v; }
    asm volatile("s_waitcnt lgkmcnt(0)" ::: "memory");
    const int c = lane & 7;
#pragma unroll
    for (int j = 0; j < 4; ++j) { const int n = (lane >> 3) + 8 * j; const LAS float* s = scr + (8 * c) * 33 + n;
        u32x4 o; o.x = pk2(s[0 * 33], s[1 * 33]); o.y = pk2(s[2 * 33], s[3 * 33]); o.z = pk2(s[4 * 33], s[5 * 33]); o.w = pk2(s[6 * 33], s[7 * 33]);
        *(u32x4*)(WT + (size_t)(row_off + n0 + n) * K + k0 + 8 * c) = o; }
    asm volatile("s_waitcnt lgkmcnt(0)" ::: "memory");
}
DI void p0_norm_row(const float* xrow, const float* g, bf16* orow, float* xcopy, int lane) {
    f32x4 v[8]; float s = 0.f;
#pragma unroll
    for (int j = 0; j < 8; ++j) { v[j] = xrow ? *((const f32x4*)xrow + lane + 64 * j) : (f32x4){0.f, 0.f, 0.f, 0.f}; s += (v[j].x * v[j].x + v[j].y * v[j].y) + (v[j].z * v[j].z + v[j].w * v[j].w); }
    if (xcopy) {
#pragma unroll
        for (int j = 0; j < 8; ++j) *((f32x4*)xcopy + lane + 64 * j) = v[j]; }
    const float r = __builtin_amdgcn_rsqf(wave_sum(s) * (1.0f / DM) + RMS_EPS);
#pragma unroll
    for (int j = 0; j < 8; ++j) { const f32x4 gg = *((const f32x4*)g + lane + 64 * j); const f32x4 o = v[j] * r * gg;
        u32x2 w; w.x = pk2(o.x, o.y); w.y = pk2(o.z, o.w); *((u32x2*)orow + lane + 64 * j) = w; }
}

DI int crow(int r, int hi) { return (r & 3) + 8 * (r >> 2) + 4 * hi; }
constexpr int KS_STRIDE = 144, VT_STRIDE = 584, ATT_KS = 0, ATT_VT = 288 * KS_STRIDE  , ATT_LDS = ATT_VT + 64 * VT_STRIDE;
DI void attn_unit(LAS unsigned char* lds, const bf16* proj, const bf16* Vt, bf16* atto, const float* sinks, int qb, int g) {
    const int tid = threadIdx.x, lane = tid & 63, r32 = lane & 31, hi = lane >> 5; const int wave = __builtin_amdgcn_readfirstlane(tid >> 6);
    const int tok0 = 128 * (qb - 1);
    for (int i = tid; i < 288 * 8; i += 512) {
        const int kk = i >> 3, ch = i & 7; u32x4 v = (u32x4){0u, 0u, 0u, 0u};
        if (kk < 272) { int row = (kk < 256) ? tok0 + kk : ROW_META + (kk - 256); if (row < 0) row = 0;
            v = *(const u32x4*)(proj + (size_t)row * INW + C_K + g * 64 + ch * 8); }
        *(LAS u32x4*)(lds + ATT_KS + kk * KS_STRIDE + ch * 16) = v;
    }
    for (int i = tid; i < 64 * 36; i += 512) {
        const int d = i / 36, kc = i - d * 36; u32x4 v = (u32x4){0u, 0u, 0u, 0u};
        if (kc < 34) { const int row = (kc < 32) ? tok0 + 8 * kc : ROW_META + 8 * (kc - 32);
            if (row >= 0) v = *(const u32x4*)(Vt + (size_t)(g * 64 + d) * MROWS + row); }
        LAS u32x2* dst = (LAS u32x2*)(lds + ATT_VT + d * VT_STRIDE + kc * 16);
        dst[0] = (u32x2){v.x, v.y}; dst[1] = (u32x2){v.z, v.w};
    }
    __syncthreads();
    constexpr float C1 = 0.125f * LOG2E;
#pragma unroll 1
    for (int tsk = wave; tsk < 16; tsk += 8) {
        const int hh = tsk & 3, sl = tsk >> 2, h = 4 * g + hh;
        const float sl2 = __builtin_amdgcn_exp2f(-0.5f * (float)(h + 1)) * LOG2E;
        const float sink2 = sinks[h] * LOG2E;
        const int tok = 128 * qb + 32 * sl + r32;
        bf16x8 qf[4];
#pragma unroll
        for (int ks = 0; ks < 4; ++ks) qf[ks] = *(const bf16x8*)(proj + (size_t)tok * INW + C_Q + h * 64 + 16 * ks + 8 * hi);
        f32x16 S[6];
#pragma unroll
        for (int t = 0; t < 6; ++t) {
            const int base = (t < 5) ? 32 * (sl + t) : 256;
            f32x16 a = {};
#pragma unroll
            for (int ks = 0; ks < 4; ++ks) { const bf16x8 kf = *(const LAS bf16x8*)(lds + ATT_KS + (base + r32) * KS_STRIDE + (16 * ks + 8 * hi) * 2);
                a = __builtin_amdgcn_mfma_f32_32x32x16_bf16(kf, qf[ks], a, 0, 0, 0); }
            S[t] = a; __builtin_amdgcn_sched_barrier(0);
        }
        int rb = r32 - 4 * hi; asm volatile("" : "+v"(rb));
        const float negb = -sl2 * (float)rb;
        float mx = sink2;
#pragma unroll
        for (int t = 0; t < 6; ++t) {
            const bool tile_dead = (t < 5) && (qb == 0) && (sl + t < 4);
#pragma unroll
            for (int r = 0; r < 16; ++r) {
                const int cc = (r & 3) + 8 * (r >> 2);
                float v; bool ok;
                if (t < 5) { v = fmaf(S[t][r], C1, fmaf(-sl2, (float)(128 - 32 * t - cc), negb));
                             ok = !tile_dead && (t != 0 || rb <= cc) && (t != 4 || cc <= rb); }
                else { v = S[t][r] * C1; ok = (r < 8); }
                v = ok ? v : -1e30f; S[t][r] = v; mx = fmaxf(mx, v);
            }
        }
        mx = fmaxf(mx, __shfl_xor(mx, 32));
        float sum = 0.f;
#pragma unroll
        for (int t = 0; t < 6; ++t)
#pragma unroll
            for (int r = 0; r < 16; ++r) { const float e = __builtin_amdgcn_exp2f(S[t][r] - mx); S[t][r] = e; sum += e; }
        sum += __shfl_xor(sum, 32);
        const float inv = 1.0f / (sum + __builtin_amdgcn_exp2f(sink2 - mx));
        f32x16 O[2]; O[0] = (f32x16){}; O[1] = (f32x16){};
#pragma unroll
        for (int t = 0; t < 6; ++t) {
            const int base = (t < 5) ? 32 * (sl + t) : 256;
#pragma unroll
            for (int ks = 0; ks < 2; ++ks) {
                u32x4 pw; pw.x = pk2(S[t][8 * ks + 0] * inv, S[t][8 * ks + 1] * inv); pw.y = pk2(S[t][8 * ks + 2] * inv, S[t][8 * ks + 3] * inv);
                pw.z = pk2(S[t][8 * ks + 4] * inv, S[t][8 * ks + 5] * inv); pw.w = pk2(S[t][8 * ks + 6] * inv, S[t][8 * ks + 7] * inv);
                const bf16x8 pb = __builtin_bit_cast(bf16x8, pw);
#pragma unroll
                for (int dt = 0; dt < 2; ++dt) {
                    const LAS unsigned char* vp = lds + ATT_VT + (r32 + 32 * dt) * VT_STRIDE + (base + 16 * ks + 4 * hi) * 2;
                    const u32x2 v0 = *(const LAS u32x2*)vp, v1 = *(const LAS u32x2*)(vp + 16);
                    const u32x4 vw = (u32x4){v0.x, v0.y, v1.x, v1.y};
                    O[dt] = __builtin_amdgcn_mfma_f32_32x32x16_bf16(__builtin_bit_cast(bf16x8, vw), pb, O[dt], 0, 0, 0);
                }
                __builtin_amdgcn_sched_barrier(0);
            }
        }
        bf16* op = atto + (size_t)tok * 1024 + h * 64;
#pragma unroll
        for (int dt = 0; dt < 2; ++dt)
#pragma unroll
            for (int gq = 0; gq < 4; ++gq) { u32x2 w; w.x = pk2(O[dt][4 * gq + 0], O[dt][4 * gq + 1]); w.y = pk2(O[dt][4 * gq + 2], O[dt][4 * gq + 3]);
                *(u32x2*)(op + 32 * dt + 8 * gq + 4 * hi) = w; }
    }
    __syncthreads();
}

constexpr int SA_LDS_PER_WAVE = 4096;
DI void sample_attn_task(LAS unsigned char* wlds, const bf16* proj, const float* cmk, const float* cmv, const float* cwk, const float* cwv, const float* sinks,
                         bf16* atto, float* out_wk, float* out_wv, int b, int g, int lane) {
    LAS float* qs = (LAS float*)wlds; LAS float* sc = (LAS float*)(wlds + 1024);
    const size_t row = (size_t)(ROW_SAMP + b);
#pragma unroll
    for (int hh = 0; hh < 4; ++hh) qs[hh * 64 + lane] = bf2f(proj[row * INW + C_Q + (4 * g + hh) * 64 + lane]);
    asm volatile("s_waitcnt lgkmcnt(0)" ::: "memory");
#pragma unroll 1
    for (int rr = 0; rr < 3; ++rr) {
        const int j = lane + 64 * rr;
        float s0 = 0.f, s1 = 0.f, s2 = 0.f, s3 = 0.f;
        if (j < 145) {
            if (j < 144) {
                const float* kp = (j < 16) ? cmk + ((size_t)(b * 16 + j) * 4 + g) * 64 : cwk + ((size_t)(b * 128 + (j - 16)) * 4 + g) * 64;
                float* okp = (j >= 17) ? out_wk + ((size_t)(b * 128 + (j - 17)) * 4 + g) * 64 : nullptr;
#pragma unroll 4
                for (int d4 = 0; d4 < 16; ++d4) { const f32x4 kv = *((const f32x4*)kp + d4);
                    if (okp) *((f32x4*)okp + d4) = kv;
                    const f32x4 q0 = *(const LAS f32x4*)(qs + 0 * 64 + 4 * d4), q1 = *(const LAS f32x4*)(qs + 1 * 64 + 4 * d4), q2 = *(const LAS f32x4*)(qs + 2 * 64 + 4 * d4), q3 = *(const LAS f32x4*)(qs + 3 * 64 + 4 * d4);
                    s0 += q0.x * kv.x + q0.y * kv.y + q0.z * kv.z + q0.w * kv.w; s1 += q1.x * kv.x + q1.y * kv.y + q1.z * kv.z + q1.w * kv.w;
                    s2 += q2.x * kv.x + q2.y * kv.y + q2.z * kv.z + q2.w * kv.w; s3 += q3.x * kv.x + q3.y * kv.y + q3.z * kv.z + q3.w * kv.w; }
            } else {
                const bf16* kp = proj + row * INW + C_K + g * 64; float* okp = out_wk + ((size_t)(b * 128 + 127) * 4 + g) * 64;
#pragma unroll 4
                for (int d4 = 0; d4 < 16; ++d4) { const u32x2 w = *((const u32x2*)kp + d4); const f32x4 kv = (f32x4){bflo(w.x), bfhi(w.x), bflo(w.y), bfhi(w.y)};
                    *((f32x4*)okp + d4) = kv;
                    const f32x4 q0 = *(const LAS f32x4*)(qs + 0 * 64 + 4 * d4), q1 = *(const LAS f32x4*)(qs + 1 * 64 + 4 * d4), q2 = *(const LAS f32x4*)(qs + 2 * 64 + 4 * d4), q3 = *(const LAS f32x4*)(qs + 3 * 64 + 4 * d4);
                    s0 += q0.x * kv.x + q0.y * kv.y + q0.z * kv.z + q0.w * kv.w; s1 += q1.x * kv.x + q1.y * kv.y + q1.z * kv.z + q1.w * kv.w;
                    s2 += q2.x * kv.x + q2.y * kv.y + q2.z * kv.z + q2.w * kv.w; s3 += q3.x * kv.x + q3.y * kv.y + q3.z * kv.z + q3.w * kv.w; }
            }
            const float dist = (j < 16) ? 0.f : (float)(144 - j);
            const float b0 = __builtin_amdgcn_exp2f(-0.5f * (float)(4 * g + 1)), b1 = __builtin_amdgcn_exp2f(-0.5f * (float)(4 * g + 2)), b2 = __builtin_amdgcn_exp2f(-0.5f * (float)(4 * g + 3)), b3 = __builtin_amdgcn_exp2f(-0.5f * (float)(4 * g + 4));
            sc[0 * 160 + j] = s0 * 0.125f - b0 * dist; sc[1 * 160 + j] = s1 * 0.125f - b1 * dist; sc[2 * 160 + j] = s2 * 0.125f - b2 * dist; sc[3 * 160 + j] = s3 * 0.125f - b3 * dist;
        }
    }
    asm volatile("s_waitcnt lgkmcnt(0)" ::: "memory");
#pragma unroll
    for (int hh = 0; hh < 4; ++hh) {
        const float sink = sinks[4 * g + hh];
        float v[3]; float mx = sink;
#pragma unroll
        for (int rr = 0; rr < 3; ++rr) { const int j = lane + 64 * rr; v[rr] = (j < 145) ? sc[hh * 160 + j] : -1e30f; mx = fmaxf(mx, v[rr]); }
        mx = wave_max(mx);
        float sum = 0.f;
#pragma unroll
        for (int rr = 0; rr < 3; ++rr) { v[rr] = __builtin_amdgcn_exp2f((v[rr] - mx) * LOG2E); sum += v[rr]; }
        sum = wave_sum(sum);
        const float inv = 1.0f / (sum + __builtin_amdgcn_exp2f((sink - mx) * LOG2E));
#pragma unroll
        for (int rr = 0; rr < 3; ++rr) { const int j = lane + 64 * rr; if (j < 145) sc[hh * 160 + j] = v[rr] * inv; }
    }
    asm volatile("s_waitcnt lgkmcnt(0)" ::: "memory");
    float o0 = 0.f, o1 = 0.f, o2 = 0.f, o3 = 0.f;
#pragma unroll 4
    for (int j = 0; j < 144; ++j) {
        const float* vp = (j < 16) ? cmv + ((size_t)(b * 16 + j) * 4 + g) * 64 : cwv + ((size_t)(b * 128 + (j - 16)) * 4 + g) * 64;
        const float vv = vp[lane];
        if (j >= 17) out_wv[((size_t)(b * 128 + (j - 17)) * 4 + g) * 64 + lane] = vv;
        o0 += sc[0 * 160 + j] * vv; o1 += sc[1 * 160 + j] * vv; o2 += sc[2 * 160 + j] * vv; o3 += sc[3 * 160 + j] * vv;
    }
    { const float vv = bf2f(proj[row * INW + C_V + g * 64 + lane]);
      out_wv[((size_t)(b * 128 + 127) * 4 + g) * 64 + lane] = vv;
      o0 += sc[0 * 160 + 144] * vv; o1 += sc[1 * 160 + 144] * vv; o2 += sc[2 * 160 + 144] * vv; o3 += sc[3 * 160 + 144] * vv; }
    bf16* op = atto + row * 1024 + (4 * g) * 64 + lane;
    op[0] = (bf16)(pk2(o0, 0.f) & 0xffffu); op[64] = (bf16)(pk2(o1, 0.f) & 0xffffu); op[128] = (bf16)(pk2(o2, 0.f) & 0xffffu); op[192] = (bf16)(pk2(o3, 0.f) & 0xffffu);
    asm volatile("s_waitcnt lgkmcnt(0)" ::: "memory");
}

constexpr int LRU_G = 0;
constexpr int LRU_XCF = 65536;
constexpr int LRU_XCB = 98304;
constexpr int LRU_CARRY = 115712;
constexpr int LRU_LDS = 119808;
struct LruP { const bf16* proj; const bf16* wg; const float* conv_w; const float* conv_b; const float* bgx; const float* bga; const float* aparam;
              const float* state_conv; const float* state_h; float* agg; bf16* lruo; float* out_hs; };
template <int MODE>
DI void lru_unit(LAS unsigned char* lds, const LruP& P, int seqc  , int n, const LAS float* carry) {
    const int tid = threadIdx.x, lane = tid & 63; const int wave = __builtin_amdgcn_readfirstlane(tid >> 6);
    LAS float* G = (LAS float*)(lds + LRU_G); LAS float* XE = G; LAS float* XCF = (LAS float*)(lds + LRU_XCF);
    const int nrows = (MODE != 2 && seqc == 0) ? 16 : 64;
    const int row0 = (MODE == 2) ? ROW_SAMP + 64 * seqc : (seqc == 0 ? ROW_META : 64 * (seqc - 1));
    const int ch = tid & 127, cg = n * 128 + ch;
    if (MODE != 2) {
        for (int i = tid; i < 67 * 128; i += 512) { const int e = i >> 7; int t = e - 3; float v = 0.f;
            if (t < nrows) { int row = -1;
                if (seqc == 0) { if (t >= 0) row = ROW_META + t; }
                else { const int tokn = 64 * (seqc - 1) + t; row = (tokn >= 0) ? tokn : ROW_META + 16 + tokn; }
                if (row >= 0) v = bf2f(P.proj[(size_t)row * INW + C_XB + n * 128 + (i & 127)]); }
            XE[i] = v; }
        __syncthreads();
    }
    { const float w0 = P.conv_w[0 * LRUW + cg], w1 = P.conv_w[1 * LRUW + cg], w2 = P.conv_w[2 * LRUW + cg], w3 = P.conv_w[3 * LRUW + cg], cb = P.conv_b[cg];
      float xc[16];
#pragma unroll
      for (int k = 0; k < 16; ++k) { const int t = (tid >> 7) + 4 * k;
          if (MODE != 2) xc[k] = w0 * XE[(t + 0) * 128 + ch] + w1 * XE[(t + 1) * 128 + ch] + w2 * XE[(t + 2) * 128 + ch] + w3 * XE[(t + 3) * 128 + ch] + cb;
          else { const int b = 64 * seqc + t; const float* scp = P.state_conv + (size_t)b * 3 * LRUW + cg;
                 xc[k] = w0 * scp[0] + w1 * scp[LRUW] + w2 * scp[2 * LRUW] + w3 * bf2f(P.proj[(size_t)(row0 + t) * INW + C_XB + cg]) + cb; } }
      if (MODE != 2) __syncthreads();
#pragma unroll
      for (int k = 0; k < 16; ++k) { const int t = (tid >> 7) + 4 * k; const float v = (t < nrows) ? xc[k] : 0.f; XCF[t * 128 + ch] = v;
          *(LAS bf16*)(lds + LRU_XCB + t * 272 + ch * 2) = (bf16)(pk2(v, 0.f) & 0xffffu); } }
    __syncthreads();
    { const int r32 = lane & 31, hi = lane >> 5;
      f32x16 acc0 = {}, acc1 = {};
      const bf16* wp = P.wg + ((size_t)(n * 256 + 32 * wave + r32)) * 128 + 8 * hi;
#pragma unroll
      for (int ks = 0; ks < 8; ++ks) {
          const bf16x8 bw = *(const bf16x8*)(wp + 16 * ks);
          const bf16x8 a0 = *(const LAS bf16x8*)(lds + LRU_XCB + r32 * 272 + (16 * ks + 8 * hi) * 2);
          const bf16x8 a1 = *(const LAS bf16x8*)(lds + LRU_XCB + (r32 + 32) * 272 + (16 * ks + 8 * hi) * 2);
          acc0 = __builtin_amdgcn_mfma_f32_32x32x16_bf16(a0, bw, acc0, 0, 0, 0);
          acc1 = __builtin_amdgcn_mfma_f32_32x32x16_bf16(a1, bw, acc1, 0, 0, 0);
      }
      const int col = 32 * wave + r32;
      const float bias = (wave < 4) ? P.bgx[n * 128 + col] : P.bga[n * 128 + col - 128];
#pragma unroll
      for (int r = 0; r < 16; ++r) { const int t = crow(r, hi); G[t * 256 + col] = sigm(acc0[r] + bias); G[(t + 32) * 256 + col] = sigm(acc1[r] + bias); }
    }
    __syncthreads();
    { const float ap = P.aparam[cg]; const float ex = __expf(-ap);
      const float sp = (ex < 0.03f) ? ex * (1.0f - ex * (0.5f - ex * (0.333333333f - ex * (0.25f - ex * 0.2f)))) : logf(1.0f + ex);
#pragma unroll
      for (int k = 0; k < 16; ++k) { const int t = (tid >> 7) + 4 * k;
          const float gx = G[t * 256 + ch], ga = G[t * 256 + 128 + ch], xc = XCF[t * 128 + ch];
          const float loga = -8.0f * ga * sp; const float a = __builtin_amdgcn_exp2f(LOG2E * loga); const float bb = sqrtf(neg_expm1(2.0f * loga)) * gx * xc;
          G[t * 256 + ch] = a; G[t * 256 + 128 + ch] = bb; } }
    __syncthreads();
    if (MODE == 0) {
        if (tid < 128) { float h = 0.f, p = 1.f;
            for (int t = 0; t < nrows; ++t) { const float a = G[t * 256 + ch], bb = G[t * 256 + 128 + ch]; h = a * h + bb; p *= a; }
            P.agg[((size_t)seqc * 2 + 0) * LRUW + cg] = p; P.agg[((size_t)seqc * 2 + 1) * LRUW + cg] = h; }
    } else if (MODE == 1) {
        if (tid < 128) { float h = carry[ch];
            for (int t = 0; t < 64; ++t) { const float a = G[t * 256 + ch], bb = G[t * 256 + 128 + ch]; h = a * h + bb; G[t * 256 + ch] = h; } }
        __syncthreads();
    } else {
#pragma unroll
        for (int k = 0; k < 16; ++k) { const int t = (tid >> 7) + 4 * k; const int b = 64 * seqc + t;
            const float h = G[t * 256 + ch] * P.state_h[(size_t)b * LRUW + cg] + G[t * 256 + 128 + ch]; G[t * 256 + ch] = h; P.out_hs[(size_t)b * LRUW + cg] = h; }
        __syncthreads();
    }
    if (MODE != 0) {
        for (int i = tid; i < 64 * 16; i += 512) { const int t = i >> 4, c8 = (i & 15) * 8; const size_t row = (size_t)(row0 + t);
            const u32x4 y = *(const u32x4*)(P.proj + row * INW + C_YB + n * 128 + c8);
            const f32x4 h0 = *(const LAS f32x4*)(G + t * 256 + c8), h1 = *(const LAS f32x4*)(G + t * 256 + c8 + 4);
            u32x4 w; w.x = pk2(gelu_tanh(bflo(y.x)) * h0.x, gelu_tanh(bfhi(y.x)) * h0.y); w.y = pk2(gelu_tanh(bflo(y.y)) * h0.z, gelu_tanh(bfhi(y.y)) * h0.w);
            w.z = pk2(gelu_tanh(bflo(y.z)) * h1.x, gelu_tanh(bfhi(y.z)) * h1.y); w.w = pk2(gelu_tanh(bflo(y.w)) * h1.z, gelu_tanh(bfhi(y.w)) * h1.w);
            *(u32x4*)(P.lruo + row * 1024 + n * 128 + c8) = w; }
    }
    __syncthreads();
}

__global__ void __launch_bounds__(NWAVES * 64, 2) griffin_fwd(Args args) {
    extern __shared__ __attribute__((aligned(16))) unsigned char lds_raw[];
    LAS unsigned char* lds = (LAS unsigned char*)lds_raw;
    const int tid = threadIdx.x, lane = tid & 63; const int wave = __builtin_amdgcn_readfirstlane(tid >> 6);
    const int G = gridDim.x, bx = blockIdx.x;
    const int gw = bx * NWAVES + wave, NGW = G * NWAVES;
    unsigned char* ws = args.ws; float* out = args.out;
    const float* x_prompt = args.in[0]; const float* x_sample = args.in[1];
    bf16* Wo_t = (bf16*)(ws + WS_WO); bf16* Wup_t = (bf16*)(ws + WS_WUP); bf16* Wdn_t = (bf16*)(ws + WS_WDN); bf16* Wlru_t = (bf16*)(ws + WS_WLRU); bf16* Watt_t = (bf16*)(ws + WS_WATT);
    bf16* Wg_t = (bf16*)(ws + WS_WG); bf16* Win_t = (bf16*)(ws + WS_WIN);
    bf16* XN = (bf16*)(ws + WS_B); bf16* PROJ = (bf16*)(ws + WS_PROJ); bf16* VT = (bf16*)(ws + WS_VT);
    bf16* LRUO = (bf16*)(ws + WS_LRUO); bf16* ATTO = (bf16*)(ws + WS_ATTO); bf16* MERGED = (bf16*)(ws + WS_C); bf16* HB = (bf16*)(ws + WS_B); bf16* UB = (bf16*)(ws + WS_U);
    float* TAILF = (float*)(ws + WS_TAILF); float* XTAIL = (float*)(ws + WS_XTAIL); float* AGG = (float*)(ws + WS_AGG); float* SS = (float*)(ws + WS_SS);
    const int lo = args.ph_lo, hi_ph = args.ph_hi;
#ifndef P2_PARTS
#define P2_PARTS 31
#endif
#ifndef PH_MASK
#define PH_MASK 0x1ff
#endif
#define IN(k) (((PH_MASK >> (k)) & 1) && lo <= (k) && (k) < hi_ph)
#if MK_N_LAUNCHES == 1
#define GRID_BAR(k) do { if (IN(k) && IN((k) + 1)) { cg::this_grid().sync(); } } while (0)
#else
#define GRID_BAR(k) do { } while (0)
#endif

    if (IN(0)) {
        LAS float* scr = (LAS float*)(lds + wave * 16384);
        constexpr int I_IN = 32 * 240, I_O = 32 * 64, I_UP = 32 * 256, I_DN = 128 * 64, I_L = 16 * 64, I_G = 128;
        constexpr int NITEMS = I_IN + I_O + I_UP + I_DN + 2 * I_L + I_G;
        for (int it = gw; it < NITEMS; it += NGW) {
            int r = it;
            if (r < I_IN) { p0_transpose_item(args.in[10], DM, INW, Win_t, 0, nullptr, scr, r, lane); continue; } r -= I_IN;
            if (r < I_O) { p0_transpose_item(args.in[21], DM, DM, Wo_t, 0, nullptr, scr, r, lane); continue; } r -= I_O;
            if (r < I_UP) { p0_transpose_item(args.in[23], DM, DFF, Wup_t, 0, args.in[22], scr, r, lane); continue; } r -= I_UP;
            if (r < I_DN) { p0_transpose_item(args.in[24], DFF, DM, Wdn_t, 0, nullptr, scr, r, lane); continue; } r -= I_DN;
            if (r < I_L) { p0_transpose_item(args.in[19], LRUW, DM, Wlru_t, 0, nullptr, scr, r, lane); continue; } r -= I_L;
            if (r < I_L) { p0_transpose_item(args.in[20], LRUW, DM, Watt_t, 0, nullptr, scr, r, lane); continue; } r -= I_L;
            { const int nb = r >> 4, which = (r >> 3) & 1, sub = r & 7;
              p0_transpose_item((which ? args.in[15] : args.in[13]) + (size_t)nb * 128 * 128, 128, 128, Wg_t + (size_t)nb * 256 * 128, which * 128, nullptr, scr, sub, lane); }
        }
        for (int m = gw; m < MROWS; m += NGW) {
            const float* xr = (m < TX) ? x_prompt + (size_t)m * DM : (m < ROW_SAMP) ? args.in[8] + (size_t)(m - ROW_META) * DM : (m < ROW_PAD) ? x_sample + (size_t)(m - ROW_SAMP) * DM : nullptr;
            p0_norm_row(xr, args.in[9], XN + (size_t)m * DM, (m >= TX) ? XTAIL + (size_t)(m - TX) * DM : nullptr, lane);
        }
        for (int i = bx * 512 + tid; i < MROWS; i += G * 512) SS[i] = 0.f;
    }
    GRID_BAR(0);

    if (IN(1)) {
#pragma unroll 1
        for (int pass = 0; pass < 2; ++pass) {
            pg8::Gemm g = pass == 0 ? pg8::Gemm{XN, Win_t, MROWS, INW, DM} : pg8::Gemm{Win_t + (size_t)C_V * DM, XN, 256, MROWS, DM};
            pg8::StaticOrder S; S.init(g.M, g.N, G, bx);
            pg8::EpiBf16 E{pass == 0 ? PROJ : VT, pass == 0 ? INW : MROWS};
            pg8::gemm_phase<pg8::EpiBf16, pg8::StaticOrder, true, true>(lds, g, S, E);
        }
    }
    GRID_BAR(1);

    if (IN(2)) {
        if (P2_PARTS & 1) for (int u = bx; u < 512; u += G) attn_unit(lds, PROJ, VT, ATTO, args.in[18], u >> 2, u & 3);
        LruP LP{PROJ, Wg_t, args.in[11], args.in[12], args.in[14], args.in[16], args.in[17], args.in[6], args.in[7], AGG, LRUO, out + O_HS};
        if (P2_PARTS & 2) for (int u = bx; u < NCHUNK_SEQ * 8; u += G) lru_unit<0>(lds, LP, u >> 3, u & 7, nullptr);
        if (P2_PARTS & 4) for (int u = bx; u < 16; u += G) lru_unit<2>(lds, LP, u >> 3, u & 7, nullptr);
        if ((P2_PARTS & 8) && gw < 512) sample_attn_task(lds + wave * SA_LDS_PER_WAVE, PROJ, args.in[2], args.in[3], args.in[4], args.in[5], args.in[18], ATTO, out + O_WKS, out + O_WVS, gw >> 2, gw & 3, lane);
        const int gt = bx * 512 + tid, NT = G * 512;
        for (int i = gt; i < 16 * 256; i += NT) { const int r = i >> 8, c = i & 255; out[O_MK + i] = bf2f(PROJ[(size_t)(ROW_META + r) * INW + C_K + c]); out[O_MV + i] = bf2f(PROJ[(size_t)(ROW_META + r) * INW + C_V + c]); }
        for (int i = gt; i < 128 * 256; i += NT) { const int r = i >> 8, c = i & 255; out[O_WK + i] = bf2f(PROJ[(size_t)(TX - 128 + r) * INW + C_K + c]); out[O_WV + i] = bf2f(PROJ[(size_t)(TX - 128 + r) * INW + C_V + c]); }
        for (int i = gt; i < 3 * 1024; i += NT) { const int r = i >> 10, c = i & 1023; out[O_CONV + i] = bf2f(PROJ[(size_t)(TX - 3 + r) * INW + C_XB + c]); }
        for (int i = gt; i < 128 * 3 * 1024; i += NT) { const int b = i / 3072, r = (i / 1024) % 3, c = i & 1023;
            out[O_CONVS + i] = (r < 2) ? args.in[6][((size_t)b * 3 + r + 1) * LRUW + c] : bf2f(PROJ[(size_t)(ROW_SAMP + b) * INW + C_XB + c]); }
        for (int i = gt; i < (16 + 112) * 128; i += NT) { const int rr = i >> 7, c8 = (i & 127) * 8; const int row = (rr < 16) ? ROW_META + rr : ROW_PAD + (rr - 16);
            *(u32x4*)(ATTO + (size_t)row * 1024 + c8) = (u32x4){0u, 0u, 0u, 0u}; *(u32x4*)(LRUO + (size_t)row * 1024 + c8) = (u32x4){0u, 0u, 0u, 0u}; }
    }
    GRID_BAR(2);

    if (IN(3)) {
        LruP LP{PROJ, Wg_t, args.in[11], args.in[12], args.in[14], args.in[16], args.in[17], args.in[6], args.in[7], AGG, LRUO, out + O_HS};
        const int n = bx & 7, cb = bx >> 3, cstep = G >> 3;
        LAS float* carry = (LAS float*)(lds + LRU_CARRY);
        if (tid < 128) { float h = 0.f; int nextc = cb, slot = 0;
            for (int k = 0; k < NCHUNK_SEQ; ++k) {
                if (k == nextc + 1) { if (slot < 8) carry[slot * 128 + tid] = h; ++slot; nextc += cstep; }
                const float a = AGG[((size_t)k * 2 + 0) * LRUW + n * 128 + tid], bb = AGG[((size_t)k * 2 + 1) * LRUW + n * 128 + tid]; h = a * h + bb; }
            if (cb == 0) out[O_H + n * 128 + tid] = h; }
        __syncthreads();
        { int slot = 0; for (int c = cb; c < 256; c += cstep, ++slot) lru_unit<1>(lds, LP, c + 1, n, carry + slot * 128); }
        pg8::Gemm g{ATTO, Watt_t, MROWS, DM, 1024}; pg8::StaticOrder S; S.init(MROWS, DM, G, bx);
        pg8::EpiGateF32 E{pg8::BigBuf{out + O_Y, TAILF}, PROJ + C_GA, INW};
        pg8::gemm_phase<pg8::EpiGateF32, pg8::StaticOrder, true, true>(lds, g, S, E);
    }
    GRID_BAR(3);

    if (IN(4)) {
        pg8::Gemm g{LRUO, Wlru_t, MROWS, DM, 1024}; pg8::StaticOrder S; S.init(MROWS, DM, G, bx);
        pg8::EpiMerge E{pg8::BigBufC{out + O_Y, TAILF}, PROJ + C_GL, INW, MERGED};
        pg8::gemm_phase<pg8::EpiMerge, pg8::StaticOrder, true, true>(lds, g, S, E);
    }
    GRID_BAR(4);

    if (IN(5)) {
        pg8::Gemm g{MERGED, Wo_t, MROWS, DM, DM}; pg8::StaticOrder S; S.init(MROWS, DM, G, bx);
        pg8::EpiResid E{pg8::BigBufC{x_prompt, XTAIL}, pg8::BigBuf{out + O_Y, TAILF}, HB, SS};
        pg8::gemm_phase<pg8::EpiResid, pg8::StaticOrder, true, true>(lds, g, S, E);
    }
    GRID_BAR(5);

    if (IN(6)) {
        pg8::Gemm g{HB, Wup_t, MROWS, DFF, DM}; pg8::StaticOrder S; S.init(MROWS, DFF, G, bx);
        pg8::EpiUp E{SS, UB};
        pg8::gemm_phase<pg8::EpiUp, pg8::StaticOrder, true, true>(lds, g, S, E);
    }
    GRID_BAR(6);

    if (IN(7)) {
        pg8::Gemm g{UB, Wdn_t, MROWS, DM, DFF}; pg8::StaticOrder S; S.init(MROWS, DM, G, bx);
        pg8::EpiDown E{pg8::BigBuf{out + O_Y, TAILF}};
        pg8::gemm_phase<pg8::EpiDown, pg8::StaticOrder, true, true>(lds, g, S, E);
    }
    GRID_BAR(7);

    if (IN(8)) {
        const float* gf = args.in[25];
        for (int m = gw; m < TX + NSAMP; m += NGW) {
            const float* src = (m < TX) ? out + O_Y + (size_t)m * DM : TAILF + (size_t)(16 + m - TX) * DM;
            float* dst = (m < TX) ? out + O_Y + (size_t)m * DM : out + O_YS + (size_t)(m - TX) * DM;
            f32x4 v[8]; float s = 0.f;
#pragma unroll
            for (int j = 0; j < 8; ++j) { v[j] = *((const f32x4*)src + lane + 64 * j); s += (v[j].x * v[j].x + v[j].y * v[j].y) + (v[j].z * v[j].z + v[j].w * v[j].w); }
            const float r = __builtin_amdgcn_rsqf(wave_sum(s) * (1.0f / DM) + RMS_EPS);
#pragma unroll
            for (int j = 0; j < 8; ++j) { const f32x4 gg = *((const f32x4*)gf + lane + 64 * j); *((f32x4*)dst + lane + 64 * j) = v[j] * r * gg; }
        }
    }
#undef IN
#undef GRID_BAR
}

extern "C" void kernel_launch(void* const* d_in, const int* in_sizes, int n_in, void* d_out, int out_size, void* d_ws, size_t ws_size, hipStream_t stream) {
    static int grid = 0;
    if (grid == 0) {
        if (n_in != 26 || (size_t)out_size != O_END || ws_size < WS_END) { fprintf(stderr, "kernel_launch: unexpected shapes (n_in %d, out %d, ws %zu)\n", n_in, out_size, ws_size); grid = -1; return; }
        int dev = 0, cus = 0, per_cu = 0;
        if (hipGetDevice(&dev) != hipSuccess || hipDeviceGetAttribute(&cus, hipDeviceAttributeMultiprocessorCount, dev) != hipSuccess) { grid = -1; return; }
        if (hipFuncSetAttribute((const void*)griffin_fwd, hipFuncAttributeMaxDynamicSharedMemorySize, LDS_BYTES) != hipSuccess) { fprintf(stderr, "kernel_launch: hipFuncSetAttribute failed\n"); grid = -1; return; }
        if (hipOccupancyMaxActiveBlocksPerMultiprocessor(&per_cu, (const void*)griffin_fwd, NWAVES * 64, LDS_BYTES) != hipSuccess || per_cu < 1) { fprintf(stderr, "kernel_launch: occupancy query says %d\n", per_cu); (void)hipGetLastError(); grid = -1; return; }
        grid = cus;
        if (grid % 8 != 0 || grid > 256) { fprintf(stderr, "kernel_launch: unexpected CU count %d\n", cus); if (grid > 256) grid = 256; }
    }
    if (grid < 0) return;
    Args a{};
    for (int i = 0; i < 26; ++i) a.in[i] = (const float*)d_in[i];
    a.out = (float*)d_out; a.ws = (unsigned char*)d_ws;
    if (MK_N_LAUNCHES == 1) {
        a.ph_lo = 0; a.ph_hi = N_PHASES;
        void* kargs[] = {&a};
        hipError_t e = hipLaunchCooperativeKernel((const void*)griffin_fwd, dim3(grid), dim3(NWAVES * 64), kargs, LDS_BYTES, stream);
        if (e != hipSuccess) fprintf(stderr, "kernel_launch: cooperative launch failed: %s (grid %d)\n", hipGetErrorString(e), grid);
    } else {
        for (int p = 0; p < N_PHASES; ++p) { a.ph_lo = p; a.ph_hi = p + 1; hipLaunchKernelGGL(griffin_fwd, dim3(grid), dim3(NWAVES * 64), LDS_BYTES, stream, a); }
    }
}
```

```cpp
#include <hip/hip_runtime.h>
#include <hip/hip_cooperative_groups.h>
#include <cstdio>
#include <cstdint>
namespace cg = cooperative_groups;

#ifndef MK_N_LAUNCHES
#define MK_N_LAUNCHES 1
#endif
constexpr int N_PHASES = 9;

namespace pg8 {
#define PG8_LAS __attribute__((address_space(3)))
typedef unsigned short bf16_t;
typedef short bf16x8 __attribute__((ext_vector_type(8)));
typedef float f32x4 __attribute__((ext_vector_type(4)));
typedef unsigned u32x4 __attribute__((ext_vector_type(4)));
constexpr int BM = 256, BK = 64, HALF = 128, HTB = HALF * BK * 2, STAGE_BYTES = 8 * HTB, NXCD = 8, WGM = 8;

__host__ __device__ __forceinline__ int lds_byte(int r, int c) { const int st = (r >> 4) * 2 + (c >> 5), rr = r & 15, cc = c & 31, ob = rr * 64 + cc * 2; return st * 1024 + (ob ^ (((ob >> 9) & 1) << 5)); }
__host__ __device__ __forceinline__ void stage_rc(int b, int& R, int& C) { const int st = b / 1024, sb = b % 1024, swz = sb ^ (((sb >> 9) & 1) << 5); R = (st >> 1) * 16 + swz / 64; C = (st & 1) * 32 + (swz % 64) / 2; }
__host__ __device__ __forceinline__ int perm32(int rho) { const int n = rho >> 4, i = rho & 15; return 8 * (i >> 2) + 4 * n + (i & 3); }

struct Unit { int pm, pn; };
struct Gemm { const bf16_t* A; const bf16_t* Bt; int M, N, K; };

struct StaticOrder {
    int nM, nN, nwg, G, c;
    __host__ __device__ void init(int M, int N, int G_, int c_) { nM = M / BM; nN = N / BM; nwg = nM * nN; G = G_; c = c_; }
    __host__ __device__ bool next(int i, Unit& u) const {
        const long L = (long)i * G + c; if (L >= nwg) return false;
        int wgid = (int)L; { const int q = nwg / NXCD, r = nwg % NXCD, xcd = wgid % NXCD, off = wgid / NXCD; wgid = (xcd < r ? xcd * (q + 1) : r * (q + 1) + (xcd - r) * q) + off; }
        const int nig = WGM * nN, gid = wgid / nig, fm = gid * WGM, gsz = (nM - fm) < WGM ? (nM - fm) : WGM;
        u.pm = fm + ((wgid % nig) % gsz); u.pn = (wgid % nig) / gsz; return true;
    }
    __device__ __forceinline__ void a_ready(const Unit&) const {}
    __device__ __forceinline__ void done(const Unit&) const {}
};

typedef float f32x2_t __attribute__((ext_vector_type(2))); typedef __bf16 bf16x2_t __attribute__((ext_vector_type(2)));
__device__ __forceinline__ unsigned cvt_pk_bf16(float lo, float hi) { f32x2_t v = {lo, hi}; bf16x2_t b = __builtin_convertvector(v, bf16x2_t); return __builtin_bit_cast(unsigned, b); }
__device__ __forceinline__ float bf_lo(unsigned w) { return __uint_as_float(w << 16); }
__device__ __forceinline__ float bf_hi(unsigned w) { return __uint_as_float(w & 0xffff0000u); }
__device__ __forceinline__ float sigmoidf_(float x) { return __builtin_amdgcn_rcpf(1.0f + __builtin_amdgcn_exp2f(-1.4426950408889634f * x)); }

struct EpiBf16 {
    static constexpr bool PERM = true;
    bf16_t* O; int ldc;
    __device__ __forceinline__ void operator()(const f32x4 (&acc)[2][2][4][2], const Unit& u, int wr, int wc, int fr, int fq) const {
        const int row0 = u.pm * BM + wr * 64 + fr; const int col0 = u.pn * BM + wc * 32 + 8 * fq;
#pragma unroll
        for (int ai = 0; ai < 2; ++ai)
#pragma unroll
            for (int m = 0; m < 4; ++m) { bf16_t* rowp = O + (size_t)(row0 + ai * HALF + m * 16) * ldc + col0;
#pragma unroll
                for (int bj = 0; bj < 2; ++bj) { const f32x4 v0 = acc[ai][bj][m][0], v1 = acc[ai][bj][m][1];
                    u32x4 w; w.x = cvt_pk_bf16(v0[0], v0[1]); w.y = cvt_pk_bf16(v0[2], v0[3]); w.z = cvt_pk_bf16(v1[0], v1[1]); w.w = cvt_pk_bf16(v1[2], v1[3]);
                    *(u32x4*)(rowp + bj * HALF) = w; } }
    }
};
struct BigBuf { float* main; float* tail;
    __device__ __forceinline__ float* tile(int pm) const { return pm < 64 ? main + (size_t)pm * 256 * 2048 : tail; } };
struct BigBufC { const float* main; const float* tail;
    __device__ __forceinline__ const float* tile(int pm) const { return pm < 64 ? main + (size_t)pm * 256 * 2048 : tail; } };

struct EpiGateF32 {
    static constexpr bool PERM = true;
    BigBuf T; const bf16_t* gate; int gld;
    __device__ __forceinline__ void operator()(const f32x4 (&acc)[2][2][4][2], const Unit& u, int wr, int wc, int fr, int fq) const {
        const int rl0 = wr * 64 + fr; const int col0 = u.pn * BM + wc * 32 + 8 * fq; float* tb = T.tile(u.pm);
#pragma unroll
        for (int ai = 0; ai < 2; ++ai)
#pragma unroll
            for (int m = 0; m < 4; ++m) { const int rl = rl0 + ai * HALF + m * 16; const bf16_t* gp = gate + (size_t)(u.pm * BM + rl) * gld + col0; float* tp = tb + (size_t)rl * 2048 + col0;
#pragma unroll
                for (int bj = 0; bj < 2; ++bj) { const u32x4 g = *(const u32x4*)(gp + bj * HALF); const f32x4 v0 = acc[ai][bj][m][0], v1 = acc[ai][bj][m][1];
                    f32x4 o0, o1;
                    o0[0] = sigmoidf_(bf_lo(g.x)) * v0[0]; o0[1] = sigmoidf_(bf_hi(g.x)) * v0[1]; o0[2] = sigmoidf_(bf_lo(g.y)) * v0[2]; o0[3] = sigmoidf_(bf_hi(g.y)) * v0[3];
                    o1[0] = sigmoidf_(bf_lo(g.z)) * v1[0]; o1[1] = sigmoidf_(bf_hi(g.z)) * v1[1]; o1[2] = sigmoidf_(bf_lo(g.w)) * v1[2]; o1[3] = sigmoidf_(bf_hi(g.w)) * v1[3];
                    *(f32x4*)(tp + bj * HALF) = o0; *(f32x4*)(tp + bj * HALF + 4) = o1; }
                if (m & 1) asm volatile("" ::: "memory"); }
    }
};
struct EpiMerge {
    static constexpr bool PERM = true;
    BigBufC T; const bf16_t* gate; int gld; bf16_t* O;
    __device__ __forceinline__ void operator()(const f32x4 (&acc)[2][2][4][2], const Unit& u, int wr, int wc, int fr, int fq) const {
        const int rl0 = wr * 64 + fr; const int col0 = u.pn * BM + wc * 32 + 8 * fq; const float* tb = T.tile(u.pm);
#pragma unroll
        for (int ai = 0; ai < 2; ++ai)
#pragma unroll
            for (int m = 0; m < 4; ++m) { const int rl = rl0 + ai * HALF + m * 16; const size_t grow = (size_t)(u.pm * BM + rl);
                const bf16_t* gp = gate + grow * gld + col0; const float* tp = tb + (size_t)rl * 2048 + col0; bf16_t* op = O + grow * 2048 + col0;
#pragma unroll
                for (int bj = 0; bj < 2; ++bj) { const u32x4 g = *(const u32x4*)(gp + bj * HALF); const f32x4 t0 = *(const f32x4*)(tp + bj * HALF), t1 = *(const f32x4*)(tp + bj * HALF + 4);
                    const f32x4 v0 = acc[ai][bj][m][0], v1 = acc[ai][bj][m][1];
                    f32x4 o0, o1;
                    o0[0] = sigmoidf_(bf_lo(g.x)) * v0[0] + t0[0]; o0[1] = sigmoidf_(bf_hi(g.x)) * v0[1] + t0[1]; o0[2] = sigmoidf_(bf_lo(g.y)) * v0[2] + t0[2]; o0[3] = sigmoidf_(bf_hi(g.y)) * v0[3] + t0[3];
                    o1[0] = sigmoidf_(bf_lo(g.z)) * v1[0] + t1[0]; o1[1] = sigmoidf_(bf_hi(g.z)) * v1[1] + t1[1]; o1[2] = sigmoidf_(bf_lo(g.w)) * v1[2] + t1[2]; o1[3] = sigmoidf_(bf_hi(g.w)) * v1[3] + t1[3];
                    u32x4 w; w.x = cvt_pk_bf16(o0[0], o0[1]); w.y = cvt_pk_bf16(o0[2], o0[3]); w.z = cvt_pk_bf16(o1[0], o1[1]); w.w = cvt_pk_bf16(o1[2], o1[3]);
                    *(u32x4*)(op + bj * HALF) = w; }
                if (m & 1) asm volatile("" ::: "memory"); }
    }
};
struct EpiResid {
    static constexpr bool PERM = true;
    BigBufC X; BigBuf Hh; bf16_t* HB; float* ss;
    __device__ __forceinline__ void operator()(const f32x4 (&acc)[2][2][4][2], const Unit& u, int wr, int wc, int fr, int fq) const {
        const int rl0 = wr * 64 + fr; const int col0 = u.pn * BM + wc * 32 + 8 * fq; const float* xb = X.tile(u.pm); float* hb_ = Hh.tile(u.pm);
#pragma unroll
        for (int ai = 0; ai < 2; ++ai)
#pragma unroll
            for (int m = 0; m < 4; ++m) { const int rl = rl0 + ai * HALF + m * 16; const size_t grow = (size_t)(u.pm * BM + rl);
                const float* xp = xb + (size_t)rl * 2048 + col0; float* hp = hb_ + (size_t)rl * 2048 + col0; bf16_t* op = HB + grow * 2048 + col0; float q = 0.f;
#pragma unroll
                for (int bj = 0; bj < 2; ++bj) { const f32x4 x0 = *(const f32x4*)(xp + bj * HALF), x1 = *(const f32x4*)(xp + bj * HALF + 4);
                    const f32x4 o0 = acc[ai][bj][m][0] + x0, o1 = acc[ai][bj][m][1] + x1;
                    q += (o0[0] * o0[0] + o0[1] * o0[1]) + (o0[2] * o0[2] + o0[3] * o0[3]) + (o1[0] * o1[0] + o1[1] * o1[1]) + (o1[2] * o1[2] + o1[3] * o1[3]);
                    *(f32x4*)(hp + bj * HALF) = o0; *(f32x4*)(hp + bj * HALF + 4) = o1;
                    u32x4 w; w.x = cvt_pk_bf16(o0[0], o0[1]); w.y = cvt_pk_bf16(o0[2], o0[3]); w.z = cvt_pk_bf16(o1[0], o1[1]); w.w = cvt_pk_bf16(o1[2], o1[3]);
                    *(u32x4*)(op + bj * HALF) = w; }
                q += __shfl_xor(q, 16); q += __shfl_xor(q, 32);
                if (fq == 0) atomicAdd(ss + grow, q);
                if (m & 1) asm volatile("" ::: "memory"); }
    }
};
struct EpiUp {
    static constexpr bool PERM = true;
    const float* ss; bf16_t* O;
    __device__ __forceinline__ void operator()(const f32x4 (&acc)[2][2][4][2], const Unit& u, int wr, int wc, int fr, int fq) const {
        const int row0 = u.pm * BM + wr * 64 + fr; const int col0 = u.pn * BM + wc * 32 + 8 * fq;
        float rs[2][4];
#pragma unroll
        for (int ai = 0; ai < 2; ++ai)
#pragma unroll
            for (int m = 0; m < 4; ++m) rs[ai][m] = __builtin_amdgcn_rsqf(ss[row0 + ai * HALF + m * 16] * (1.0f / 2048.0f) + 1e-6f);
#pragma unroll
        for (int ai = 0; ai < 2; ++ai)
#pragma unroll
            for (int m = 0; m < 4; ++m) { bf16_t* rowp = O + (size_t)(row0 + ai * HALF + m * 16) * 8192 + col0; const float r = rs[ai][m];
#pragma unroll
                for (int bj = 0; bj < 2; ++bj) { f32x4 v0 = acc[ai][bj][m][0] * r, v1 = acc[ai][bj][m][1] * r;
#pragma unroll
                    for (int j = 0; j < 4; ++j) { const float a = fmaxf(v0[j], 0.f), b = fmaxf(v1[j], 0.f); v0[j] = a * a; v1[j] = b * b; }
                    u32x4 w; w.x = cvt_pk_bf16(v0[0], v0[1]); w.y = cvt_pk_bf16(v0[2], v0[3]); w.z = cvt_pk_bf16(v1[0], v1[1]); w.w = cvt_pk_bf16(v1[2], v1[3]);
                    *(u32x4*)(rowp + bj * HALF) = w; } }
    }
};
struct EpiDown {
    static constexpr bool PERM = true;
    BigBuf Hh;
    __device__ __forceinline__ void operator()(const f32x4 (&acc)[2][2][4][2], const Unit& u, int wr, int wc, int fr, int fq) const {
        const int rl0 = wr * 64 + fr; const int col0 = u.pn * BM + wc * 32 + 8 * fq; float* hb_ = Hh.tile(u.pm);
#pragma unroll
        for (int ai = 0; ai < 2; ++ai)
#pragma unroll
            for (int m = 0; m < 4; ++m) { const int rl = rl0 + ai * HALF + m * 16; float* hp = hb_ + (size_t)rl * 2048 + col0;
#pragma unroll
                for (int bj = 0; bj < 2; ++bj) { const f32x4 x0 = *(const f32x4*)(hp + bj * HALF), x1 = *(const f32x4*)(hp + bj * HALF + 4);
                    *(f32x4*)(hp + bj * HALF) = acc[ai][bj][m][0] + x0; *(f32x4*)(hp + bj * HALF + 4) = acc[ai][bj][m][1] + x1; }
                if (m & 1) asm volatile("" ::: "memory"); }
    }
};

template <class Epi, class Sched, bool ALIGN_EPI = false, bool SP2 = false>
__device__ __forceinline__ void gemm_phase(PG8_LAS unsigned char* lds, const Gemm g, const Sched& S, const Epi& E) {
    const int tid = threadIdx.x, wid = __builtin_amdgcn_readfirstlane(tid >> 6), lane = tid & 63, wr = wid >> 2, wc = wid & 3, fr = lane & 15, fq = lane >> 4;
    const int K = g.K, nt = K / BK;
    unsigned voffA[2], voffB[2];
#pragma unroll
    for (int i = 0; i < 2; ++i) { int R, C; stage_rc(tid * 16 + i * 8192, R, C); const int Rb = Epi::PERM ? ((R & ~31) + perm32(R & 31)) : R;
        voffA[i] = (unsigned)(R * K + C) * 2u; voffB[i] = (unsigned)(Rb * K + C) * 2u; }
    const size_t kstep = (size_t)(BK * 2);
    const size_t hstep = (size_t)HALF * K * 2;
    const size_t tstep = 2 * hstep;
    const unsigned ldsw = (unsigned)wid * 1024u;
    const int aoff = lds_byte(wr * 64 + fr, fq * 8), boff = lds_byte(wc * 32 + fr, fq * 8);
#define PG8_SA(b, h) (((b) * 2 + (h)) * HTB)
#define PG8_SB(b, h) ((4 + (b) * 2 + (h)) * HTB)
#define PG8_STAGE(bufoff, gbase, voff) do { _Pragma("unroll") for (int _i = 0; _i < 2; ++_i) \
        __builtin_amdgcn_global_load_lds((const unsigned*)((const char*)(gbase) + (voff)[_i]), (PG8_LAS unsigned*)(lds + (bufoff) + ldsw + _i * 8192), 16, 0, 0); } while (0)
#define PG8_LDA(dst, b, h) do { _Pragma("unroll") for (int m = 0; m < 4; ++m) _Pragma("unroll") for (int k = 0; k < 2; ++k) dst[m][k] = *(const PG8_LAS bf16x8*)(lds + PG8_SA(b, h) + aoff + m * 2048 + k * 1024); } while (0)
#define PG8_LDB(dst, b, h) do { _Pragma("unroll") for (int n = 0; n < 2; ++n) _Pragma("unroll") for (int k = 0; k < 2; ++k) dst[n][k] = *(const PG8_LAS bf16x8*)(lds + PG8_SB(b, h) + boff + n * 2048 + k * 1024); } while (0)
#define PG8_MMA(ai, bj, At, Bt) do { __builtin_amdgcn_s_setprio(1); _Pragma("unroll") for (int m = 0; m < 4; ++m) _Pragma("unroll") for (int n = 0; n < 2; ++n) _Pragma("unroll") for (int k = 0; k < 2; ++k) \
        acc[ai][bj][m][n] = __builtin_amdgcn_mfma_f32_16x16x32_bf16(Bt[n][k], At[m][k], acc[ai][bj][m][n], 0, 0, 0); __builtin_amdgcn_s_setprio(0); } while (0)
#define PG8_WAIT_V(n) asm volatile("s_waitcnt vmcnt(" #n ")" ::: "memory")
#define PG8_WAIT_L(n) asm volatile("s_waitcnt lgkmcnt(" #n ")" ::: "memory")
#define PG8_BAR __builtin_amdgcn_s_barrier()
#define PG8_SCHED __builtin_amdgcn_sched_barrier(0)
    Unit cur, nxt; int ui = 0;
    if (!S.next(0, cur)) return;
    f32x4 acc[2][2][4][2];
#pragma unroll
    for (int a = 0; a < 2; ++a)
#pragma unroll
        for (int b = 0; b < 2; ++b)
#pragma unroll
            for (int m = 0; m < 4; ++m)
#pragma unroll
                for (int n = 0; n < 2; ++n) acc[a][b][m][n] = (f32x4){0.f, 0.f, 0.f, 0.f};
    bf16x8 At[4][2], B0[2][2], B1[2][2];
    const char* cA = (const char*)g.A + (size_t)cur.pm * tstep; const char* cB = (const char*)g.Bt + (size_t)cur.pn * tstep;
    S.a_ready(cur);
    if constexpr (SP2) {
        PG8_STAGE(PG8_SB(0, 0), cB, voffB); PG8_STAGE(PG8_SB(0, 1), cB + hstep, voffB); PG8_STAGE(PG8_SA(0, 0), cA, voffA); PG8_STAGE(PG8_SA(0, 1), cA + hstep, voffA);
        if (wr == 1) PG8_BAR;
        PG8_WAIT_V(2); PG8_BAR;
        PG8_STAGE(PG8_SB(1, 0), cB + kstep, voffB); PG8_STAGE(PG8_SA(1, 0), cA + kstep, voffA); PG8_STAGE(PG8_SB(1, 1), cB + hstep + kstep, voffB);
        PG8_WAIT_V(6); PG8_BAR;
    } else {
        PG8_STAGE(PG8_SB(0, 0), cB, voffB); PG8_STAGE(PG8_SA(0, 0), cA, voffA); PG8_STAGE(PG8_SB(0, 1), cB + hstep, voffB); PG8_STAGE(PG8_SA(0, 1), cA + hstep, voffA);
        if (wr == 1) PG8_BAR;
        PG8_WAIT_V(4); PG8_BAR;
        PG8_STAGE(PG8_SB(1, 0), cB + kstep, voffB); PG8_STAGE(PG8_SA(1, 0), cA + kstep, voffA); PG8_STAGE(PG8_SB(1, 1), cB + hstep + kstep, voffB);
        PG8_WAIT_V(6); PG8_BAR;
    }
    for (;;) {
        const bool has_next = S.next(ui + 1, nxt);
        const char* nA = has_next ? (const char*)g.A + (size_t)nxt.pm * tstep : cA; const char* nB = has_next ? (const char*)g.Bt + (size_t)nxt.pn * tstep : cB;
        for (int t = 0; t < nt; t += 2) {
            const bool last = (t == nt - 2);
            const char* a1 = cA + (size_t)(t + 1) * kstep;
            const char* a2 = last ? nA : cA + (size_t)(t + 2) * kstep; const char* b2 = last ? nB : cB + (size_t)(t + 2) * kstep;
            const char* a3 = a2 + kstep; const char* b3 = b2 + kstep;
            if (last && has_next) S.a_ready(nxt);
            if constexpr (SP2) {
            PG8_LDB(B0, 0, 0); PG8_LDB(B1, 0, 1); PG8_SCHED; PG8_LDA(At, 0, 0); PG8_STAGE(PG8_SA(1, 1), a1 + hstep, voffA);
            PG8_WAIT_V(8); PG8_WAIT_L(0); PG8_BAR; PG8_MMA(0, 0, At, B0); PG8_MMA(0, 1, At, B1); PG8_BAR; PG8_SCHED;
            PG8_LDA(At, 0, 1); PG8_STAGE(PG8_SB(0, 0), b2, voffB); PG8_STAGE(PG8_SB(0, 1), b2 + hstep, voffB); PG8_STAGE(PG8_SA(0, 0), a2, voffA);
            PG8_WAIT_V(8); PG8_WAIT_L(0); PG8_BAR; PG8_MMA(1, 0, At, B0); PG8_MMA(1, 1, At, B1); PG8_BAR; PG8_SCHED;
            PG8_LDB(B0, 1, 0); PG8_LDB(B1, 1, 1); PG8_SCHED; PG8_LDA(At, 1, 0); PG8_STAGE(PG8_SA(0, 1), a2 + hstep, voffA);
            PG8_WAIT_V(8); PG8_WAIT_L(0); PG8_BAR; PG8_MMA(0, 0, At, B0); PG8_MMA(0, 1, At, B1); PG8_BAR; PG8_SCHED;
            PG8_LDA(At, 1, 1); PG8_STAGE(PG8_SB(1, 0), b3, voffB); PG8_STAGE(PG8_SB(1, 1), b3 + hstep, voffB); PG8_STAGE(PG8_SA(1, 0), a3, voffA);
            PG8_WAIT_V(8); PG8_WAIT_L(0); PG8_BAR; PG8_MMA(1, 0, At, B0); PG8_MMA(1, 1, At, B1); PG8_BAR; PG8_SCHED;
            } else {
            PG8_LDB(B0, 0, 0); PG8_SCHED; PG8_LDA(At, 0, 0); PG8_STAGE(PG8_SA(1, 1), a1 + hstep, voffA);
            PG8_WAIT_L(8); PG8_BAR; PG8_WAIT_L(0); PG8_MMA(0, 0, At, B0); PG8_BAR; PG8_SCHED;
            PG8_LDB(B1, 0, 1); PG8_STAGE(PG8_SB(0, 0), b2, voffB);
            PG8_BAR; PG8_WAIT_L(0); PG8_MMA(0, 1, At, B1); PG8_BAR;
            PG8_LDA(At, 0, 1); PG8_STAGE(PG8_SA(0, 0), a2, voffA);
            PG8_BAR; PG8_WAIT_L(0); PG8_MMA(1, 0, At, B0); PG8_BAR; PG8_SCHED;
            PG8_STAGE(PG8_SB(0, 1), b2 + hstep, voffB);
            PG8_WAIT_V(6); PG8_BAR; PG8_MMA(1, 1, At, B1); PG8_BAR;
            PG8_LDB(B0, 1, 0); PG8_SCHED; PG8_LDA(At, 1, 0); PG8_STAGE(PG8_SA(0, 1), a2 + hstep, voffA);
            PG8_WAIT_L(8); PG8_BAR; PG8_WAIT_L(0); PG8_MMA(0, 0, At, B0); PG8_BAR; PG8_SCHED;
            PG8_LDB(B1, 1, 1); PG8_STAGE(PG8_SB(1, 0), b3, voffB);
            PG8_BAR; PG8_WAIT_L(0); PG8_MMA(0, 1, At, B1); PG8_BAR;
            PG8_LDA(At, 1, 1); PG8_STAGE(PG8_SA(1, 0), a3, voffA);
            PG8_BAR; PG8_WAIT_L(0); PG8_MMA(1, 0, At, B0); PG8_BAR; PG8_SCHED;
            PG8_STAGE(PG8_SB(1, 1), b3 + hstep, voffB);
            PG8_WAIT_V(6); PG8_BAR; PG8_MMA(1, 1, At, B1); PG8_BAR;
            }
        }
        if constexpr (ALIGN_EPI) { if (wr == 0) PG8_BAR; }
        E(acc, cur, wr, wc, fr, fq); S.done(cur);
        if (!has_next) break;
#pragma unroll
        for (int a = 0; a < 2; ++a)
#pragma unroll
            for (int b = 0; b < 2; ++b)
#pragma unroll
                for (int m = 0; m < 4; ++m)
#pragma unroll
                    for (int n = 0; n < 2; ++n) acc[a][b][m][n] = (f32x4){0.f, 0.f, 0.f, 0.f};
        cur = nxt; cA = nA; cB = nB; ++ui;
        if constexpr (ALIGN_EPI) { if (wr == 1) PG8_BAR; }
    }
    PG8_WAIT_V(0);
    if constexpr (!ALIGN_EPI) { if (wr == 0) PG8_BAR; }
    PG8_BAR;
#undef PG8_SA
#undef PG8_SB
#undef PG8_STAGE
#undef PG8_LDA
#undef PG8_LDB
#undef PG8_MMA
#undef PG8_WAIT_V
#undef PG8_WAIT_L
#undef PG8_BAR
#undef PG8_SCHED
}
}

typedef unsigned short bf16;
typedef float f32x4 __attribute__((ext_vector_type(4)));
typedef float f32x16 __attribute__((ext_vector_type(16)));
typedef short bf16x8 __attribute__((ext_vector_type(8)));
typedef unsigned u32x4 __attribute__((ext_vector_type(4)));
typedef unsigned u32x2 __attribute__((ext_vector_type(2)));
#define LAS __attribute__((address_space(3)))
#define DI __device__ __forceinline__

constexpr int DM = 2048, TX = 16384, NMETA = 16, NSAMP = 128, MROWS = 16640;
constexpr int ROW_META = 16384, ROW_SAMP = 16400, ROW_PAD = 16528;
constexpr int LRUW = 1024, INW = 7680, DFF = 8192, NWAVES = 8;
constexpr int C_XB = 0, C_YB = 1024, C_Q = 2048, C_K = 3072, C_V = 3328, C_GL = 3584, C_GA = 5632;
constexpr float RMS_EPS = 1e-6f, LOG2E = 1.4426950408889634f;
constexpr size_t O_Y = 0, O_YS = 33554432, O_MK = 33816576, O_MV = 33820672, O_WK = 33824768, O_WV = 33857536, O_CONV = 33890304, O_H = 33893376,
                 O_WKS = 33894400, O_WVS = 38088704, O_CONVS = 42283008, O_HS = 42676224, O_END = 42807296;
constexpr size_t MiB = 1u << 20;
constexpr size_t WS_WO = 1 * MiB, WS_WUP = 9 * MiB, WS_WDN = 41 * MiB, WS_WLRU = 73 * MiB, WS_WATT = 77 * MiB, WS_WG = 81 * MiB;
constexpr size_t WS_PROJ = 82 * MiB;
constexpr size_t WS_U = 82 * MiB;
constexpr size_t WS_B = 342 * MiB;
constexpr size_t WS_LRUO = WS_B, WS_ATTO = WS_B + (size_t)MROWS * 1024 * 2;
constexpr size_t WS_C = 407 * MiB;
constexpr size_t WS_WIN = WS_C, WS_VT = WS_C + 30 * MiB;
constexpr size_t WS_TAILF = 472 * MiB, WS_XTAIL = 474 * MiB, WS_AGG = 476 * MiB, WS_SS = 479 * MiB, WS_END = 480 * MiB;
constexpr int NCHUNK_SEQ = 257;
constexpr int LDS_BYTES = 147456;

struct Args { const float* in[26]; float* out; unsigned char* ws; int ph_lo, ph_hi; };

DI float bf2f(bf16 x) { return __uint_as_float((unsigned)x << 16); }
DI float bflo(unsigned w) { return __uint_as_float(w << 16); }
DI float bfhi(unsigned w) { return __uint_as_float(w & 0xffff0000u); }
DI unsigned pk2(float lo, float hi) { return pg8::cvt_pk_bf16(lo, hi); }
DI float wave_sum(float v) {
#pragma unroll
    for (int o = 1; o < 64; o <<= 1) v += __shfl_xor(v, o);
    return v;
}
DI float wave_max(float v) {
#pragma unroll
    for (int o = 1; o < 64; o <<= 1) v = fmaxf(v, __shfl_xor(v, o));
    return v;
}
DI float sigm(float x) { return __builtin_amdgcn_rcpf(1.0f + __builtin_amdgcn_exp2f(-LOG2E * x)); }
DI float gelu_tanh(float x) {
    const float y = 0.7978845608028654f * (x + 0.044715f * x * x * x);
    return x * sigm(2.0f * y);
}
DI float neg_expm1(float x) {
    if (x > -0.125f) { float p = 1.0f / 720.0f; p = p * x + 1.0f / 120.0f; p = p * x + 1.0f / 24.0f; p = p * x + 1.0f / 6.0f; p = p * x + 0.5f; p = p * x + 1.0f; return -(p * x); }
    return 1.0f - __builtin_amdgcn_exp2f(LOG2E * x);
}

DI void p0_transpose_item(const float* W, int K, int N, bf16* WT, int row_off, const float* kscale, LAS float* scr, int item, int lane) {
    const int nblk = N / 32, kb = item / nblk, nb = item % nblk, k0 = 64 * kb, n0 = 32 * nb;
#pragma unroll 8
    for (int i = 0; i < 32; ++i) { const int kk = 2 * i + (lane >> 5); float v = W[(size_t)(k0 + kk) * N + n0 + (lane & 31)]; if (kscale) v *= kscale[k0 + kk]; scr[kk * 33 + (lane & 31)] = v; }
    asm volatile("s_waitcnt lgkmcnt(0)" ::: "memory");
    const int c = lane & 7;
#pragma unroll
    for (int j = 0; j < 4; ++j) { const int n = (lane >> 3) + 8 * j; const LAS float* s = scr + (8 * c) * 33 + n;
        u32x4 o; o.x = pk2(s[0 * 33], s[1 * 33]); o.y = pk2(s[2 * 33], s[3 * 33]); o.z = pk2(s[4 * 33], s[5 * 33]); o.w = pk2(s[6 * 33], s[7 * 33]);
        *(u32x4*)(WT + (size_t)(row_off + n0 + n) * K + k0 + 8 * c) = o; }
    asm volatile("s_waitcnt lgkmcnt(0)" ::: "memory");
}
DI void p0_norm_row(const float* xrow, const float* g, bf16* orow, float* xcopy, int lane) {
    f32x4 v[8]; float s = 0.f;
#pragma unroll
    for (int j = 0; j < 8; ++j) { v[j] = xrow ? *((const f32x4*)xrow + lane + 64 * j) : (f32x4){0.f, 0.f, 0.f, 0.f}; s += (v[j].x * v[j].x + v[j].y * v[j].y) + (v[j].z * v[j].z + v[j].w * v[j].w); }
    if (xcopy) {
#pragma unroll
        for (int j = 0; j < 8; ++j) *((f32x4*)xcopy + lane + 64 * j) = v[j]; }
    const float r = __builtin_amdgcn_rsqf(wave_sum(s) * (1.0f / DM) + RMS_EPS);
#pragma unroll
    for (int j = 0; j < 8; ++j) { const f32x4 gg = *((const f32x4*)g + lane + 64 * j); const f32x4 o = v[j] * r * gg;
        u32x2 w; w.x = pk2(o.x, o.y); w.y = pk2(o.z, o.w); *((u32x2*)orow + lane + 64 * j) = w; }
}

DI int crow(int r, int hi) { return (r & 3) + 8 * (r >> 2) + 4 * hi; }
constexpr int KS_STRIDE = 144, VT_STRIDE = 584, ATT_KS = 0, ATT_VT = 288 * KS_STRIDE  , ATT_LDS = ATT_VT + 64 * VT_STRIDE;
DI void attn_unit(LAS unsigned char* lds, const bf16* proj, const bf16* Vt, bf16* atto, const float* sinks, int qb, int g) {
    const int tid = threadIdx.x, lane = tid & 63, r32 = lane & 31, hi = lane >> 5; const int wave = __builtin_amdgcn_readfirstlane(tid >> 6);
    const int tok0 = 128 * (qb - 1);
    for (int i = tid; i < 288 * 8; i += 512) {
        const int kk = i >> 3, ch = i & 7; u32x4 v = (u32x4){0u, 0u, 0u, 0u};
        if (kk < 272) { int row = (kk < 256) ? tok0 + kk : ROW_META + (kk - 256); if (row < 0) row = 0;
            v = *(const u32x4*)(proj + (size_t)row * INW + C_K + g * 64 + ch * 8); }
        *(LAS u32x4*)(lds + ATT_KS + kk * KS_STRIDE + ch * 16) = v;
    }
    for (int i = tid; i < 64 * 36; i += 512) {
        const int d = i / 36, kc = i - d * 36; u32x4 v = (u32x4){0u, 0u, 0u, 0u};
        if (kc < 34) { const int row = (kc < 32) ? tok0 + 8 * kc : ROW_META + 8 * (kc - 32);
            if (row >= 0) v = *(const u32x4*)(Vt + (size_t)(g * 64 + d) * MROWS + row); }
        LAS u32x2* dst = (LAS u32x2*)(lds + ATT_VT + d * VT_STRIDE + kc * 16);
        dst[0] = (u32x2){v.x, v.y}; dst[1] = (u32x2){v.z, v.w};
    }
    __syncthreads();
    constexpr float C1 = 0.125f * LOG2E;
#pragma unroll 1
    for (int tsk = wave; tsk < 16; tsk += 8) {
        const int hh = tsk & 3, sl = tsk >> 2, h = 4 * g + hh;
        const float sl2 = __builtin_amdgcn_exp2f(-0.5f * (float)(h + 1)) * LOG2E;
        const float sink2 = sinks[h] * LOG2E;
        const int tok = 128 * qb + 32 * sl + r32;
        bf16x8 qf[4];
#pragma unroll
        for (int ks = 0; ks < 4; ++ks) qf[ks] = *(const bf16x8*)(proj + (size_t)tok * INW + C_Q + h * 64 + 16 * ks + 8 * hi);
        f32x16 S[6];
#pragma unroll
        for (int t = 0; t < 6; ++t) {
            const int base = (t < 5) ? 32 * (sl + t) : 256;
            f32x16 a = {};
#pragma unroll
            for (int ks = 0; ks < 4; ++ks) { const bf16x8 kf = *(const LAS bf16x8*)(lds + ATT_KS + (base + r32) * KS_STRIDE + (16 * ks + 8 * hi) * 2);
                a = __builtin_amdgcn_mfma_f32_32x32x16_bf16(kf, qf[ks], a, 0, 0, 0); }
            S[t] = a; __builtin_amdgcn_sched_barrier(0);
        }
        int rb = r32 - 4 * hi; asm volatile("" : "+v"(rb));
        const float negb = -sl2 * (float)rb;
        float mx = sink2;
#pragma unroll
        for (int t = 0; t < 6; ++t) {
            const bool tile_dead = (t < 5) && (qb == 0) && (sl + t < 4);
#pragma unroll
            for (int r = 0; r < 16; ++r) {
                const int cc = (r & 3) + 8 * (r >> 2);
                float v; bool ok;
                if (t < 5) { v = fmaf(S[t][r], C1, fmaf(-sl2, (float)(128 - 32 * t - cc), negb));
                             ok = !tile_dead && (t != 0 || rb <= cc) && (t != 4 || cc <= rb); }
                else { v = S[t][r] * C1; ok = (r < 8); }
                v = ok ? v : -1e30f; S[t][r] = v; mx = fmaxf(mx, v);
            }
        }
        mx = fmaxf(mx, __shfl_xor(mx, 32));
        float sum = 0.f;
#pragma unroll
        for (int t = 0; t < 6; ++t)
#pragma unroll
            for (int r = 0; r < 16; ++r) { const float e = __builtin_amdgcn_exp2f(S[t][r] - mx); S[t][r] = e; sum += e; }
        sum += __shfl_xor(sum, 32);
        const float inv = 1.0f / (sum + __builtin_amdgcn_exp2f(sink2 - mx));
        f32x16 O[2]; O[0] = (f32x16){}; O[1] = (f32x16){};
#pragma unroll
        for (int t = 0; t < 6; ++t) {
            const int base = (t < 5) ? 32 * (sl + t) : 256;
#pragma unroll
            for (int ks = 0; ks < 2; ++ks) {
                u32x4 pw; pw.x = pk2(S[t][8 * ks + 0] * inv, S[t][8 * ks + 1] * inv); pw.y = pk2(S[t][8 * ks + 2] * inv, S[t][8 * ks + 3] * inv);
                pw.z = pk2(S[t][8 * ks + 4] * inv, S[t][8 * ks + 5] * inv); pw.w = pk2(S[t][8 * ks + 6] * inv, S[t][8 * ks + 7] * inv);
                const bf16x8 pb = __builtin_bit_cast(bf16x8, pw);
#pragma unroll
                for (int dt = 0; dt < 2; ++dt) {
                    const LAS unsigned char* vp = lds + ATT_VT + (r32 + 32 * dt) * VT_STRIDE + (base + 16 * ks + 4 * hi) * 2;
                    const u32x2 v0 = *(const LAS u32x2*)vp, v1 = *(const LAS u32x2*)(vp + 16);
                    const u32x4 vw = (u32x4){v0.x, v0.y, v1.x, v1.y};
                    O[dt] = __builtin_amdgcn_mfma_f32_32x32x16_bf16(__builtin_bit_cast(bf16x8, vw), pb, O[dt], 0, 0, 0);
                }
                __builtin_amdgcn_sched_barrier(0);
            }
        }
        bf16* op = atto + (size_t)tok * 1024 + h * 64;
#pragma unroll
        for (int dt = 0; dt < 2; ++dt)
#pragma unroll
            for (int gq = 0; gq < 4; ++gq) { u32x2 w; w.x = pk2(O[dt][4 * gq + 0], O[dt][4 * gq + 1]); w.y = pk2(O[dt][4 * gq + 2], O[dt][4 * gq + 3]);
                *(u32x2*)(op + 32 * dt + 8 * gq + 4 * hi) = w; }
    }
    __syncthreads();
}

constexpr int SA_LDS_PER_WAVE = 4096;
DI void sample_attn_task(LAS unsigned char* wlds, const bf16* proj, const float* cmk, const float* cmv, const float* cwk, const float* cwv, const float* sinks,
                         bf16* atto, float* out_wk, float* out_wv, int b, int g, int lane) {
    LAS float* qs = (LAS float*)wlds; LAS float* sc = (LAS float*)(wlds + 1024);
    const size_t row = (size_t)(ROW_SAMP + b);
#pragma unroll
    for (int hh = 0; hh < 4; ++hh) qs[hh * 64 + lane] = bf2f(proj[row * INW + C_Q + (4 * g + hh) * 64 + lane]);
    asm volatile("s_waitcnt lgkmcnt(0)" ::: "memory");
#pragma unroll 1
    for (int rr = 0; rr < 3; ++rr) {
        const int j = lane + 64 * rr;
        float s0 = 0.f, s1 = 0.f, s2 = 0.f, s3 = 0.f;
        if (j < 145) {
            if (j < 144) {
                const float* kp = (j < 16) ? cmk + ((size_t)(b * 16 + j) * 4 + g) * 64 : cwk + ((size_t)(b * 128 + (j - 16)) * 4 + g) * 64;
                float* okp = (j >= 17) ? out_wk + ((size_t)(b * 128 + (j - 17)) * 4 + g) * 64 : nullptr;
#pragma unroll 4
                for (int d4 = 0; d4 < 16; ++d4) { const f32x4 kv = *((const f32x4*)kp + d4);
                    if (okp) *((f32x4*)okp + d4) = kv;
                    const f32x4 q0 = *(const LAS f32x4*)(qs + 0 * 64 + 4 * d4), q1 = *(const LAS f32x4*)(qs + 1 * 64 + 4 * d4), q2 = *(const LAS f32x4*)(qs + 2 * 64 + 4 * d4), q3 = *(const LAS f32x4*)(qs + 3 * 64 + 4 * d4);
                    s0 += q0.x * kv.x + q0.y * kv.y + q0.z * kv.z + q0.w * kv.w; s1 += q1.x * kv.x + q1.y * kv.y + q1.z * kv.z + q1.w * kv.w;
                    s2 += q2.x * kv.x + q2.y * kv.y + q2.z * kv.z + q2.w * kv.w; s3 += q3.x * kv.x + q3.y * kv.y + q3.z * kv.z + q3.w * kv.w; }
            } else {
                const bf16* kp = proj + row * INW + C_K + g * 64; float* okp = out_wk + ((size_t)(b * 128 + 127) * 4 + g) * 64;
#pragma unroll 4
                for (int d4 = 0; d4 < 16; ++d4) { const u32x2 w = *((const u32x2*)kp + d4); const f32x4 kv = (f32x4){bflo(w.x), bfhi(w.x), bflo(w.y), bfhi(w.y)};
                    *((f32x4*)okp + d4) = kv;
                    const f32x4 q0 = *(const LAS f32x4*)(qs + 0 * 64 + 4 * d4), q1 = *(const LAS f32x4*)(qs + 1 * 64 + 4 * d4), q2 = *(const LAS f32x4*)(qs + 2 * 64 + 4 * d4), q3 = *(const LAS f32x4*)(qs + 3 * 64 + 4 * d4);
                    s0 += q0.x * kv.x + q0.y * kv.y + q0.z * kv.z + q0.w * kv.w; s1 += q1.x * kv.x + q1.y * kv.y + q1.z * kv.z + q1.w * kv.w;
                    s2 += q2.x * kv.x + q2.y * kv.y + q2.z * kv.z + q2.w * kv.w; s3 += q3.x * kv.x + q3.y * kv.y + q3.z * kv.z + q3.w * kv.w; }
            }
            const float dist = (j < 16) ? 0.f : (float)(144 - j);
            const float b0 = __builtin_amdgcn_exp2f(-0.5f * (float)(4 * g + 1)), b1 = __builtin_amdgcn_exp2f(-0.5f * (float)(4 * g + 2)), b2 = __builtin_amdgcn_exp2f(-0.5f * (float)(4 * g + 3)), b3 = __builtin_amdgcn_exp2f(-0.5f * (float)(4 * g + 4));
            sc[0 * 160 + j] = s0 * 0.125f - b0 * dist; sc[1 * 160 + j] = s1 * 0.125f - b1 * dist; sc[2 * 160 + j] = s2 * 0.125f - b2 * dist; sc[3 * 160 + j] = s3 * 0.125f - b3 * dist;
        }
    }
    asm volatile("s_waitcnt lgkmcnt(0)" ::: "memory");
#pragma unroll
    for (int hh = 0; hh < 4; ++hh) {
        const float sink = sinks[4 * g + hh];
        float v[3]; float mx = sink;
#pragma unroll
        for (int rr = 0; rr < 3; ++rr) { const int j = lane + 64 * rr; v[rr] = (j < 145) ? sc[hh * 160 + j] : -1e30f; mx = fmaxf(mx, v[rr]); }
        mx = wave_max(mx);
        float sum = 0.f;
#pragma unroll
        for (int rr = 0; rr < 3; ++rr) { v[rr] = __builtin_amdgcn_exp2f((v[rr] - mx) * LOG2E); sum += v[rr]; }
        sum = wave_sum(sum);
        const float inv = 1.0f / (sum + __builtin_amdgcn_exp2f((sink - mx) * LOG2E));
#pragma unroll
        for (int rr = 0; rr < 3; ++rr) { const int j = lane + 64 * rr; if (j < 145) sc[hh * 160 + j] = v[rr] * inv; }
    }
    asm volatile("s_waitcnt lgkmcnt(0)" ::: "memory");
    float o0 = 0.f, o1 = 0.f, o2 = 0.f, o3 = 0.f;
#pragma unroll 4
    for (int j = 0; j < 144; ++j) {
        const float* vp = (j < 16) ? cmv + ((size_t)(b * 16 + j) * 4 + g) * 64 : cwv + ((size_t)(b * 128 + (j - 16)) * 4 + g) * 64;
        const float vv = vp[lane];
        if (j >= 17) out_wv[((size_t)(b * 128 + (j - 17)) * 4 + g) * 64 + lane] = vv;
        o0 += sc[0 * 160 + j] * vv; o1 += sc[1 * 160 + j] * vv; o2 += sc[2 * 160 + j] * vv; o3 += sc[3 * 160 + j] * vv;
    }
    { const float vv = bf2f(proj[row * INW + C_V + g * 64 + lane]);
      out_wv[((size_t)(b * 128 + 127) * 4 + g) * 64 + lane] = vv;
      o0 += sc[0 * 160 + 144] * vv; o1 += sc[1 * 160 + 144] * vv; o2 += sc[2 * 160 + 144] * vv; o3 += sc[3 * 160 + 144] * vv; }
    bf16* op = atto + row * 1024 + (4 * g) * 64 + lane;
    op[0] = (bf16)(pk2(o0, 0.f) & 0xffffu); op[64] = (bf16)(pk2(o1, 0.f) & 0xffffu); op[128] = (bf16)(pk2(o2, 0.f) & 0xffffu); op[192] = (bf16)(pk2(o3, 0.f) & 0xffffu);
    asm volatile("s_waitcnt lgkmcnt(0)" ::: "memory");
}

constexpr int LRU_G = 0;
constexpr int LRU_XCF = 65536;
constexpr int LRU_XCB = 98304;
constexpr int LRU_CARRY = 115712;
constexpr int LRU_LDS = 119808;
struct LruP { const bf16* proj; const bf16* wg; const float* conv_w; const float* conv_b; const float* bgx; const float* bga; const float* aparam;
              const float* state_conv; const float* state_h; float* agg; bf16* lruo; float* out_hs; };
template <int MODE>
DI void lru_unit(LAS unsigned char* lds, const LruP& P, int seqc  , int n, const LAS float* carry) {
    const int tid = threadIdx.x, lane = tid & 63; const int wave = __builtin_amdgcn_readfirstlane(tid >> 6);
    LAS float* G = (LAS float*)(lds + LRU_G); LAS float* XE = G; LAS float* XCF = (LAS float*)(lds + LRU_XCF);
    const int nrows = (MODE != 2 && seqc == 0) ? 16 : 64;
    const int row0 = (MODE == 2) ? ROW_SAMP + 64 * seqc : (seqc == 0 ? ROW_META : 64 * (seqc - 1));
    const int ch = tid & 127, cg = n * 128 + ch;
    if (MODE != 2) {
        for (int i = tid; i < 67 * 128; i += 512) { const int e = i >> 7; int t = e - 3; float v = 0.f;
            if (t < nrows) { int row = -1;
                if (seqc == 0) { if (t >= 0) row = ROW_META + t; }
                else { const int tokn = 64 * (seqc - 1) + t; row = (tokn >= 0) ? tokn : ROW_META + 16 + tokn; }
                if (row >= 0) v = bf2f(P.proj[(size_t)row * INW + C_XB + n * 128 + (i & 127)]); }
            XE[i] = v; }
        __syncthreads();
    }
    { const float w0 = P.conv_w[0 * LRUW + cg], w1 = P.conv_w[1 * LRUW + cg], w2 = P.conv_w[2 * LRUW + cg], w3 = P.conv_w[3 * LRUW + cg], cb = P.conv_b[cg];
      float xc[16];
#pragma unroll
      for (int k = 0; k < 16; ++k) { const int t = (tid >> 7) + 4 * k;
          if (MODE != 2) xc[k] = w0 * XE[(t + 0) * 128 + ch] + w1 * XE[(t + 1) * 128 + ch] + w2 * XE[(t + 2) * 128 + ch] + w3 * XE[(t + 3) * 128 + ch] + cb;
          else { const int b = 64 * seqc + t; const float* scp = P.state_conv + (size_t)b * 3 * LRUW + cg;
                 xc[k] = w0 * scp[0] + w1 * scp[LRUW] + w2 * scp[2 * LRUW] + w3 * bf2f(P.proj[(size_t)(row0 + t) * INW + C_XB + cg]) + cb; } }
      if (MODE != 2) __syncthreads();
#pragma unroll
      for (int k = 0; k < 16; ++k) { const int t = (tid >> 7) + 4 * k; const float v = (t < nrows) ? xc[k] : 0.f; XCF[t * 128 + ch] = v;
          *(LAS bf16*)(lds + LRU_XCB + t * 272 + ch * 2) = (bf16)(pk2(v, 0.f) & 0xffffu); } }
    __syncthreads();
    { const int r32 = lane & 31, hi = lane >> 5;
      f32x16 acc0 = {}, acc1 = {};
      const bf16* wp = P.wg + ((size_t)(n * 256 + 32 * wave + r32)) * 128 + 8 * hi;
#pragma unroll
      for (int ks = 0; ks < 8; ++ks) {
          const bf16x8 bw = *(const bf16x8*)(wp + 16 * ks);
          const bf16x8 a0 = *(const LAS bf16x8*)(lds + LRU_XCB + r32 * 272 + (16 * ks + 8 * hi) * 2);
          const bf16x8 a1 = *(const LAS bf16x8*)(lds + LRU_XCB + (r32 + 32) * 272 + (16 * ks + 8 * hi) * 2);
          acc0 = __builtin_amdgcn_mfma_f32_32x32x16_bf16(a0, bw, acc0, 0, 0, 0);
          acc1 = __builtin_amdgcn_mfma_f32_32x32x16_bf16(a1, bw, acc1, 0, 0, 0);
      }
      const int col = 32 * wave + r32;
      const float bias = (wave < 4) ? P.bgx[n * 128 + col] : P.bga[n * 128 + col - 128];
#pragma unroll
      for (int r = 0; r < 16; ++r) { const int t = crow(r, hi); G[t * 256 + col] = sigm(acc0[r] + bias); G[(t + 32) * 256 + col] = sigm(acc1[r] + bias); }
    }
    __syncthreads();
    { const float ap = P.aparam[cg]; const float ex = __expf(-ap);
      const float sp = (ex < 0.03f) ? ex * (1.0f - ex * (0.5f - ex * (0.333333333f - ex * (0.25f - ex * 0.2f)))) : logf(1.0f + ex);
#pragma unroll
      for (int k = 0; k < 16; ++k) { const int t = (tid >> 7) + 4 * k;
          const float gx = G[t * 256 + ch], ga = G[t * 256 + 128 + ch], xc = XCF[t * 128 + ch];
          const float loga = -8.0f * ga * sp; const float a = __builtin_amdgcn_exp2f(LOG2E * loga); const float bb = sqrtf(neg_expm1(2.0f * loga)) * gx * xc;
          G[t * 256 + ch] = a; G[t * 256 + 128 + ch] = bb; } }
    __syncthreads();
    if (MODE == 0) {
        if (tid < 128) { float h = 0.f, p = 1.f;
            for (int t = 0; t < nrows; ++t) { const float a = G[t * 256 + ch], bb = G[t * 256 + 128 + ch]; h = a * h + bb; p *= a; }
            P.agg[((size_t)seqc * 2 + 0) * LRUW + cg] = p; P.agg[((size_t)seqc * 2 + 1) * LRUW + cg] = h; }
    } else if (MODE == 1) {
        if (tid < 128) { float h = carry[ch];
            for (int t = 0; t < 64; ++t) { const float a = G[t * 256 + ch], bb = G[t * 256 + 128 + ch]; h = a * h + bb; G[t * 256 + ch] = h; } }
        __syncthreads();
    } else {
#pragma unroll
        for (int k = 0; k < 16; ++k) { const int t = (tid >> 7) + 4 * k; const int b = 64 * seqc + t;
            const float h = G[t * 256 + ch] * P.state_h[(size_t)b * LRUW + cg] + G[t * 256 + 128 + ch]; G[t * 256 + ch] = h; P.out_hs[(size_t)b * LRUW + cg] = h; }
        __syncthreads();
    }
    if (MODE != 0) {
        for (int i = tid; i < 64 * 16; i += 512) { const int t = i >> 4, c8 = (i & 15) * 8; const size_t row = (size_t)(row0 + t);
            const u32x4 y = *(const u32x4*)(P.proj + row * INW + C_YB + n * 128 + c8);
            const f32x4 h0 = *(const LAS f32x4*)(G + t * 256 + c8), h1 = *(const LAS f32x4*)(G + t * 256 + c8 + 4);
            u32x4 w; w.x = pk2(gelu_tanh(bflo(y.x)) * h0.x, gelu_tanh(bfhi(y.x)) * h0.y); w.y = pk2(gelu_tanh(bflo(y.y)) * h0.z, gelu_tanh(bfhi(y.y)) * h0.w);
            w.z = pk2(gelu_tanh(bflo(y.z)) * h1.x, gelu_tanh(bfhi(y.z)) * h1.y); w.w = pk2(gelu_tanh(bflo(y.w)) * h1.z, gelu_tanh(bfhi(y.w)) * h1.w);
            *(u32x4*)(P.lruo + row * 1024 + n * 128 + c8) = w; }
    }
    __syncthreads();
}


#define RLX_AGENT __ATOMIC_RELAXED, __HIP_MEMORY_SCOPE_AGENT
#define XB_TMO      128
#define XB_XCNT(j)  (256  + 64 * (j))
#define XB_XSUB(j)  (1280 + 64 * (j))
#define XB_XGEN(j)  (2304 + 64 * (j))
#define XB_TOP      3328
#define XB_TOPGEN   3392
#define XCD_BAR_WORDS 3456
#define XB_SPIN_CAP (1u << 18)
DI unsigned xb_ld(unsigned* p)              { return __hip_atomic_load(p, __ATOMIC_RELAXED, __HIP_MEMORY_SCOPE_AGENT); }
DI unsigned xb_add(unsigned* p, unsigned v) { return __hip_atomic_fetch_add(p, v, __ATOMIC_RELAXED, __HIP_MEMORY_SCOPE_AGENT); }
DI unsigned xb_xcc_id() { return (unsigned)__builtin_amdgcn_s_getreg((3 << 11) | 20) & 0xFu; }
#define XB_SPIN(cond, bar) do { unsigned _sp = 0; while (cond) { __builtin_amdgcn_s_sleep(1); \
    if ((++_sp & 255u) == 0u) { if (xb_ld(&(bar)[XB_TMO])) break; if (_sp > XB_SPIN_CAP) { atomicAdd(&(bar)[XB_TMO], 1u); break; } } } } while (0)
struct XcdBarrier { unsigned* bar; unsigned x; volatile LAS unsigned* st; };
DI XcdBarrier xcd_barrier_post(unsigned* bar, volatile LAS unsigned* st) {
    XcdBarrier b; b.bar = bar; b.x = xb_xcc_id(); b.st = st;
    if (threadIdx.x == 0) (void)xb_add(&bar[XB_XCNT(b.x)], 1u);
    return b;
}
DI void xcd_barrier_complete(unsigned* bar, unsigned x, unsigned& nloc, unsigned& nx) {
    const unsigned Gn = gridDim.x * gridDim.y * gridDim.z;
    unsigned sum, cnt, mine, sp = 0u;
    for (;;) {
        sum = 0u; cnt = 0u; mine = 0u;
#pragma unroll
        for (unsigned j = 0; j < 16; ++j) { const unsigned c = xb_ld(&bar[XB_XCNT(j)]); sum += c; cnt += (c > 0u) ? 1u : 0u; mine = (j == x) ? c : mine; }
        if (sum == Gn) break;
        __builtin_amdgcn_s_sleep(1);
        if ((++sp & 255u) == 0u) { if (xb_ld(&bar[XB_TMO])) break; if (sp > XB_SPIN_CAP) { atomicAdd(&bar[XB_TMO], 1u); break; } }
    }
    nloc = mine > 0u ? mine : 1u; nx = cnt > 0u ? cnt : 1u;
}
DI void xcd_barrier(const XcdBarrier& b) {
    asm volatile("s_waitcnt vmcnt(0)" ::: "memory");
    __syncthreads();
    if (threadIdx.x == 0) {
        unsigned* bar = b.bar;
        __builtin_amdgcn_s_waitcnt(0);
        unsigned nloc = b.st[0], nx = b.st[1];
        if (nloc == 0u) { xcd_barrier_complete(bar, b.x, nloc, nx); b.st[0] = nloc; b.st[1] = nx; }
        const unsigned old = xb_add(&bar[XB_XSUB(b.x)], 1u);
        const unsigned gen = old / nloc;
        if (old + 1u == (gen + 1u) * nloc) {
            __builtin_amdgcn_fence(__ATOMIC_RELEASE, "agent");
            asm volatile("s_waitcnt vmcnt(0)" ::: "memory");
            const unsigned og = xb_add(&bar[XB_TOP], 1u);
            const unsigned tg = og / nx;
            if (og + 1u == (tg + 1u) * nx) xb_add(&bar[XB_TOPGEN], 1u);
            else XB_SPIN(xb_ld(&bar[XB_TOPGEN]) == tg, bar);
            __builtin_amdgcn_fence(__ATOMIC_ACQUIRE, "agent");
            xb_add(&bar[XB_XGEN(b.x)], 1u);
            asm volatile("s_waitcnt vmcnt(0)" ::: "memory");
        } else {
            XB_SPIN(xb_ld(&bar[XB_XGEN(b.x)]) == gen, bar);
            __builtin_amdgcn_fence(__ATOMIC_ACQUIRE, "agent");
            asm volatile("s_waitcnt vmcnt(0)" ::: "memory");
        }
    }
    __syncthreads();
}
constexpr int MISC_OFF = 131072 + 320;
constexpr size_t WS_CTL = 0, CTL_ZERO_BYTES = 65536;
constexpr int CW_BAR = 4096;

__global__ void __launch_bounds__(NWAVES * 64, 2) griffin_fwd(Args args) {
    extern __shared__ __attribute__((aligned(16))) unsigned char lds_raw[];
    LAS unsigned char* lds = (LAS unsigned char*)lds_raw;
    const int tid = threadIdx.x, lane = tid & 63; const int wave = __builtin_amdgcn_readfirstlane(tid >> 6);
#define G ((int)gridDim.x)
#define bx ((int)blockIdx.x)
#define gw (bx * NWAVES + wave)
#define NGW (G * NWAVES)
#define ws (args.ws)
#define out (args.out)
#define x_prompt (args.in[0])
#define x_sample (args.in[1])
#define Wo_t ((bf16*)(ws + WS_WO))
#define Wup_t ((bf16*)(ws + WS_WUP))
#define Wdn_t ((bf16*)(ws + WS_WDN))
#define Wlru_t ((bf16*)(ws + WS_WLRU))
#define Watt_t ((bf16*)(ws + WS_WATT))
#define Wg_t ((bf16*)(ws + WS_WG))
#define Win_t ((bf16*)(ws + WS_WIN))
#define XN ((bf16*)(ws + WS_B))
#define PROJ ((bf16*)(ws + WS_PROJ))
#define VT ((bf16*)(ws + WS_VT))
#define LRUO ((bf16*)(ws + WS_LRUO))
#define ATTO ((bf16*)(ws + WS_ATTO))
#define MERGED ((bf16*)(ws + WS_C))
#define HB ((bf16*)(ws + WS_B))
#define UB ((bf16*)(ws + WS_U))
#define TAILF ((float*)(ws + WS_TAILF))
#define XTAIL ((float*)(ws + WS_XTAIL))
#define AGG ((float*)(ws + WS_AGG))
#define SS ((float*)(ws + WS_SS))
    const int lo = args.ph_lo, hi_ph = args.ph_hi;
#if MK_N_LAUNCHES == 1 && !defined(ALL_CG_SYNC)
    if (tid < 32) ((LAS unsigned*)(lds + MISC_OFF))[tid] = 0u;
    __syncthreads();
    const XcdBarrier xbar = xcd_barrier_post((unsigned*)(ws + WS_CTL) + CW_BAR, (volatile LAS unsigned*)(lds + MISC_OFF) + 8);
#endif
#ifndef P2_PARTS
#define P2_PARTS 31
#endif
#ifndef PH_MASK
#define PH_MASK 0x1ff
#endif
#define IN(k) (((PH_MASK >> (k)) & 1) && lo <= (k) && (k) < hi_ph)
#if MK_N_LAUNCHES == 1
#if defined(ALL_CG_SYNC)
#define GRID_BAR(k) do { if (IN(k) && IN((k) + 1)) { cg::this_grid().sync(); } } while (0)
#else
#define GRID_BAR(k) do { if (IN(k) && IN((k) + 1)) { if ((k) == 0) cg::this_grid().sync(); else xcd_barrier(xbar); } } while (0)
#endif
#else
#define GRID_BAR(k) do { } while (0)
#endif

    if (IN(0)) {
        LAS float* scr = (LAS float*)(lds + wave * 16384);
        constexpr int I_IN = 32 * 240, I_O = 32 * 64, I_UP = 32 * 256, I_DN = 128 * 64, I_L = 16 * 64, I_G = 128;
        constexpr int NITEMS = I_IN + I_O + I_UP + I_DN + 2 * I_L + I_G;
        for (int it = gw; it < NITEMS; it += NGW) {
            int r = it;
            if (r < I_IN) { p0_transpose_item(args.in[10], DM, INW, Win_t, 0, nullptr, scr, r, lane); continue; } r -= I_IN;
            if (r < I_O) { p0_transpose_item(args.in[21], DM, DM, Wo_t, 0, nullptr, scr, r, lane); continue; } r -= I_O;
            if (r < I_UP) { p0_transpose_item(args.in[23], DM, DFF, Wup_t, 0, args.in[22], scr, r, lane); continue; } r -= I_UP;
            if (r < I_DN) { p0_transpose_item(args.in[24], DFF, DM, Wdn_t, 0, nullptr, scr, r, lane); continue; } r -= I_DN;
            if (r < I_L) { p0_transpose_item(args.in[19], LRUW, DM, Wlru_t, 0, nullptr, scr, r, lane); continue; } r -= I_L;
            if (r < I_L) { p0_transpose_item(args.in[20], LRUW, DM, Watt_t, 0, nullptr, scr, r, lane); continue; } r -= I_L;
            { const int nb = r >> 4, which = (r >> 3) & 1, sub = r & 7;
              p0_transpose_item((which ? args.in[15] : args.in[13]) + (size_t)nb * 128 * 128, 128, 128, Wg_t + (size_t)nb * 256 * 128, which * 128, nullptr, scr, sub, lane); }
        }
        for (int m = gw; m < MROWS; m += NGW) {
            const float* xr = (m < TX) ? x_prompt + (size_t)m * DM : (m < ROW_SAMP) ? args.in[8] + (size_t)(m - ROW_META) * DM : (m < ROW_PAD) ? x_sample + (size_t)(m - ROW_SAMP) * DM : nullptr;
            p0_norm_row(xr, args.in[9], XN + (size_t)m * DM, (m >= TX) ? XTAIL + (size_t)(m - TX) * DM : nullptr, lane);
        }
        for (int i = bx * 512 + tid; i < MROWS; i += G * 512) SS[i] = 0.f;
    }
    GRID_BAR(0);

    if (IN(1)) {
#pragma unroll 1
        for (int pass = 0; pass < 2; ++pass) {
            pg8::Gemm g = pass == 0 ? pg8::Gemm{XN, Win_t, MROWS, INW, DM} : pg8::Gemm{Win_t + (size_t)C_V * DM, XN, 256, MROWS, DM};
            pg8::StaticOrder S; S.init(g.M, g.N, G, bx);
            pg8::EpiBf16 E{pass == 0 ? PROJ : VT, pass == 0 ? INW : MROWS};
            pg8::gemm_phase<pg8::EpiBf16, pg8::StaticOrder, true, true>(lds, g, S, E);
        }
    }
    GRID_BAR(1);

    if (IN(2)) {
        if (P2_PARTS & 1) for (int u = bx; u < 512; u += G) attn_unit(lds, PROJ, VT, ATTO, args.in[18], u >> 2, u & 3);
        LruP LP{PROJ, Wg_t, args.in[11], args.in[12], args.in[14], args.in[16], args.in[17], args.in[6], args.in[7], AGG, LRUO, out + O_HS};
        if (P2_PARTS & 2) for (int u = bx; u < NCHUNK_SEQ * 8; u += G) lru_unit<0>(lds, LP, u >> 3, u & 7, nullptr);
        if (P2_PARTS & 4) for (int u = bx; u < 16; u += G) lru_unit<2>(lds, LP, u >> 3, u & 7, nullptr);
        if ((P2_PARTS & 8) && gw < 512) sample_attn_task(lds + wave * SA_LDS_PER_WAVE, PROJ, args.in[2], args.in[3], args.in[4], args.in[5], args.in[18], ATTO, out + O_WKS, out + O_WVS, gw >> 2, gw & 3, lane);
        const int gt = bx * 512 + tid, NT = G * 512;
        for (int i = gt; i < 16 * 256; i += NT) { const int r = i >> 8, c = i & 255; out[O_MK + i] = bf2f(PROJ[(size_t)(ROW_META + r) * INW + C_K + c]); out[O_MV + i] = bf2f(PROJ[(size_t)(ROW_META + r) * INW + C_V + c]); }
        for (int i = gt; i < 128 * 256; i += NT) { const int r = i >> 8, c = i & 255; out[O_WK + i] = bf2f(PROJ[(size_t)(TX - 128 + r) * INW + C_K + c]); out[O_WV + i] = bf2f(PROJ[(size_t)(TX - 128 + r) * INW + C_V + c]); }
        for (int i = gt; i < 3 * 1024; i += NT) { const int r = i >> 10, c = i & 1023; out[O_CONV + i] = bf2f(PROJ[(size_t)(TX - 3 + r) * INW + C_XB + c]); }
        for (int i = gt; i < 128 * 3 * 1024; i += NT) { const int b = i / 3072, r = (i / 1024) % 3, c = i & 1023;
            out[O_CONVS + i] = (r < 2) ? args.in[6][((size_t)b * 3 + r + 1) * LRUW + c] : bf2f(PROJ[(size_t)(ROW_SAMP + b) * INW + C_XB + c]); }
        for (int i = gt; i < (16 + 112) * 128; i += NT) { const int rr = i >> 7, c8 = (i & 127) * 8; const int row = (rr < 16) ? ROW_META + rr : ROW_PAD + (rr - 16);
            *(u32x4*)(ATTO + (size_t)row * 1024 + c8) = (u32x4){0u, 0u, 0u, 0u}; *(u32x4*)(LRUO + (size_t)row * 1024 + c8) = (u32x4){0u, 0u, 0u, 0u}; }
    }
    GRID_BAR(2);

    if (IN(3)) {
        LruP LP{PROJ, Wg_t, args.in[11], args.in[12], args.in[14], args.in[16], args.in[17], args.in[6], args.in[7], AGG, LRUO, out + O_HS};
        const int n = bx & 7, cb = bx >> 3, cstep = G >> 3;
        LAS float* carry = (LAS float*)(lds + LRU_CARRY);
        if (tid < 128) { float h = 0.f; int nextc = cb, slot = 0;
            for (int k = 0; k < NCHUNK_SEQ; ++k) {
                if (k == nextc + 1) { if (slot < 8) carry[slot * 128 + tid] = h; ++slot; nextc += cstep; }
                const float a = AGG[((size_t)k * 2 + 0) * LRUW + n * 128 + tid], bb = AGG[((size_t)k * 2 + 1) * LRUW + n * 128 + tid]; h = a * h + bb; }
            if (cb == 0) out[O_H + n * 128 + tid] = h; }
        __syncthreads();
        { int slot = 0; for (int c = cb; c < 256; c += cstep, ++slot) lru_unit<1>(lds, LP, c + 1, n, carry + slot * 128); }
        pg8::Gemm g{ATTO, Watt_t, MROWS, DM, 1024}; pg8::StaticOrder S; S.init(MROWS, DM, G, bx);
        pg8::EpiGateF32 E{pg8::BigBuf{out + O_Y, TAILF}, PROJ + C_GA, INW};
        pg8::gemm_phase<pg8::EpiGateF32, pg8::StaticOrder, true, true>(lds, g, S, E);
    }
    GRID_BAR(3);

    if (IN(4)) {
        pg8::Gemm g{LRUO, Wlru_t, MROWS, DM, 1024}; pg8::StaticOrder S; S.init(MROWS, DM, G, bx);
        pg8::EpiMerge E{pg8::BigBufC{out + O_Y, TAILF}, PROJ + C_GL, INW, MERGED};
        pg8::gemm_phase<pg8::EpiMerge, pg8::StaticOrder, true, true>(lds, g, S, E);
    }
    GRID_BAR(4);

    if (IN(5)) {
        pg8::Gemm g{MERGED, Wo_t, MROWS, DM, DM}; pg8::StaticOrder S; S.init(MROWS, DM, G, bx);
        pg8::EpiResid E{pg8::BigBufC{x_prompt, XTAIL}, pg8::BigBuf{out + O_Y, TAILF}, HB, SS};
        pg8::gemm_phase<pg8::EpiResid, pg8::StaticOrder, true, true>(lds, g, S, E);
    }
    GRID_BAR(5);

    if (IN(6)) {
        pg8::Gemm g{HB, Wup_t, MROWS, DFF, DM}; pg8::StaticOrder S; S.init(MROWS, DFF, G, bx);
        pg8::EpiUp E{SS, UB};
        pg8::gemm_phase<pg8::EpiUp, pg8::StaticOrder, true, true>(lds, g, S, E);
    }
    GRID_BAR(6);

    if (IN(7)) {
        pg8::Gemm g{UB, Wdn_t, MROWS, DM, DFF}; pg8::StaticOrder S; S.init(MROWS, DM, G, bx);
        pg8::EpiDown E{pg8::BigBuf{out + O_Y, TAILF}};
        pg8::gemm_phase<pg8::EpiDown, pg8::StaticOrder, true, true>(lds, g, S, E);
    }
    GRID_BAR(7);

    if (IN(8)) {
        const float* gf = args.in[25];
        for (int m = gw; m < TX + NSAMP; m += NGW) {
            const float* src = (m < TX) ? out + O_Y + (size_t)m * DM : TAILF + (size_t)(16 + m - TX) * DM;
            float* dst = (m < TX) ? out + O_Y + (size_t)m * DM : out + O_YS + (size_t)(m - TX) * DM;
            f32x4 v[8]; float s = 0.f;
#pragma unroll
            for (int j = 0; j < 8; ++j) { v[j] = *((const f32x4*)src + lane + 64 * j); s += (v[j].x * v[j].x + v[j].y * v[j].y) + (v[j].z * v[j].z + v[j].w * v[j].w); }
            const float r = __builtin_amdgcn_rsqf(wave_sum(s) * (1.0f / DM) + RMS_EPS);
#pragma unroll
            for (int j = 0; j < 8; ++j) { const f32x4 gg = *((const f32x4*)gf + lane + 64 * j); *((f32x4*)dst + lane + 64 * j) = v[j] * r * gg; }
        }
    }
#undef IN
#undef GRID_BAR
#undef G
#undef bx
#undef gw
#undef NGW
#undef ws
#undef out
#undef x_prompt
#undef x_sample
}

extern "C" void kernel_launch(void* const* d_in, const int* in_sizes, int n_in, void* d_out, int out_size, void* d_ws, size_t ws_size, hipStream_t stream) {
    static int grid = 0;
    if (grid == 0) {
        if (n_in != 26 || (size_t)out_size != O_END || ws_size < WS_END) { fprintf(stderr, "kernel_launch: unexpected shapes (n_in %d, out %d, ws %zu)\n", n_in, out_size, ws_size); grid = -1; return; }
        int dev = 0, cus = 0, per_cu = 0;
        if (hipGetDevice(&dev) != hipSuccess || hipDeviceGetAttribute(&cus, hipDeviceAttributeMultiprocessorCount, dev) != hipSuccess) { grid = -1; return; }
        if (hipFuncSetAttribute((const void*)griffin_fwd, hipFuncAttributeMaxDynamicSharedMemorySize, LDS_BYTES) != hipSuccess) { fprintf(stderr, "kernel_launch: hipFuncSetAttribute failed\n"); grid = -1; return; }
        if (hipOccupancyMaxActiveBlocksPerMultiprocessor(&per_cu, (const void*)griffin_fwd, NWAVES * 64, LDS_BYTES) != hipSuccess || per_cu < 1) { fprintf(stderr, "kernel_launch: occupancy query says %d\n", per_cu); (void)hipGetLastError(); grid = -1; return; }
        grid = cus;
        if (grid % 8 != 0 || grid > 256) { fprintf(stderr, "kernel_launch: unexpected CU count %d\n", cus); if (grid > 256) grid = 256; }
    }
    if (grid < 0) return;
    Args a{};
    for (int i = 0; i < 26; ++i) a.in[i] = (const float*)d_in[i];
    a.out = (float*)d_out; a.ws = (unsigned char*)d_ws;
    if (MK_N_LAUNCHES == 1) {
        a.ph_lo = 0; a.ph_hi = N_PHASES;
        if (hipMemsetAsync((char*)d_ws + WS_CTL, 0, CTL_ZERO_BYTES, stream) != hipSuccess) { fprintf(stderr, "kernel_launch: hipMemsetAsync failed\n"); return; }
        void* kargs[] = {&a};
        hipError_t e = hipLaunchCooperativeKernel((const void*)griffin_fwd, dim3(grid), dim3(NWAVES * 64), kargs, LDS_BYTES, stream);
        if (e != hipSuccess) fprintf(stderr, "kernel_launch: cooperative launch failed: %s (grid %d)\n", hipGetErrorString(e), grid);
    } else {
        for (int p = 0; p < N_PHASES; ++p) { a.ph_lo = p; a.ph_hi = p + 1; hipLaunchKernelGGL(griffin_fwd, dim3(grid), dim3(NWAVES * 64), LDS_BYTES, stream, a); }
    }
}
```

```cpp
#include <hip/hip_runtime.h>
#include <hip/hip_cooperative_groups.h>
#include <cstdio>
#include <cstdint>
namespace cg = cooperative_groups;

#ifndef MK_N_LAUNCHES
#define MK_N_LAUNCHES 1
#endif
constexpr int N_PHASES = 9;

namespace pg8 {
#define PG8_LAS __attribute__((address_space(3)))
typedef unsigned short bf16_t;
typedef short bf16x8 __attribute__((ext_vector_type(8)));
typedef float f32x4 __attribute__((ext_vector_type(4)));
typedef unsigned u32x4 __attribute__((ext_vector_type(4)));
constexpr int BM = 256, BK = 64, HALF = 128, HTB = HALF * BK * 2, STAGE_BYTES = 8 * HTB, NXCD = 8, WGM = 8;

__host__ __device__ __forceinline__ int lds_byte(int r, int c) { const int st = (r >> 4) * 2 + (c >> 5), rr = r & 15, cc = c & 31, ob = rr * 64 + cc * 2; return st * 1024 + (ob ^ (((ob >> 9) & 1) << 5)); }
__host__ __device__ __forceinline__ void stage_rc(int b, int& R, int& C) { const int st = b / 1024, sb = b % 1024, swz = sb ^ (((sb >> 9) & 1) << 5); R = (st >> 1) * 16 + swz / 64; C = (st & 1) * 32 + (swz % 64) / 2; }
__host__ __device__ __forceinline__ int perm32(int rho) { const int n = rho >> 4, i = rho & 15; return 8 * (i >> 2) + 4 * n + (i & 3); }

struct Unit { int pm, pn, kind; };
struct Gemm { const bf16_t* A; const bf16_t* Bt; int M, N, K; };

struct StaticOrder {
    int nM, nN, nwg, G, c;
    __host__ __device__ void init(int M, int N, int G_, int c_) { nM = M / BM; nN = N / BM; nwg = nM * nN; G = G_; c = c_; }
    __host__ __device__ bool next(int i, Unit& u) const {
        const long L = (long)i * G + c; if (L >= nwg) return false;
        int wgid = (int)L; { const int q = nwg / NXCD, r = nwg % NXCD, xcd = wgid % NXCD, off = wgid / NXCD; wgid = (xcd < r ? xcd * (q + 1) : r * (q + 1) + (xcd - r) * q) + off; }
        const int nig = WGM * nN, gid = wgid / nig, fm = gid * WGM, gsz = (nM - fm) < WGM ? (nM - fm) : WGM;
        u.pm = fm + ((wgid % nig) % gsz); u.pn = (wgid % nig) / gsz; u.kind = 0; return true;
    }
    __device__ __forceinline__ const char* a_tile(const Gemm& g, const Unit& u, size_t tstep) const { return (const char*)g.A + (size_t)u.pm * tstep; }
    __device__ __forceinline__ const char* b_tile(const Gemm& g, const Unit& u, size_t tstep) const { return (const char*)g.Bt + (size_t)u.pn * tstep; }
    __device__ __forceinline__ void a_ready(const Unit&) const {}
    __device__ __forceinline__ void done(const Unit&) const {}
};
struct ProjOrder : StaticOrder {
    int n1, vtile;
    __host__ __device__ bool next(int i, Unit& u) const {
        const long L = (long)i * G + c; if (L < nwg) return StaticOrder::next(i, u);
        if (L >= nwg + n1) return false;
        u.pm = 0; u.pn = (int)(L - nwg); u.kind = 1; return true;
    }
    __device__ __forceinline__ const char* a_tile(const Gemm& g, const Unit& u, size_t tstep) const { return u.kind ? (const char*)g.Bt + (size_t)vtile * tstep : (const char*)g.A + (size_t)u.pm * tstep; }
    __device__ __forceinline__ const char* b_tile(const Gemm& g, const Unit& u, size_t tstep) const { return u.kind ? (const char*)g.A + (size_t)u.pn * tstep : (const char*)g.Bt + (size_t)u.pn * tstep; }
};

typedef float f32x2_t __attribute__((ext_vector_type(2))); typedef __bf16 bf16x2_t __attribute__((ext_vector_type(2)));
__device__ __forceinline__ unsigned cvt_pk_bf16(float lo, float hi) { f32x2_t v = {lo, hi}; bf16x2_t b = __builtin_convertvector(v, bf16x2_t); return __builtin_bit_cast(unsigned, b); }
__device__ __forceinline__ float bf_lo(unsigned w) { return __uint_as_float(w << 16); }
__device__ __forceinline__ float bf_hi(unsigned w) { return __uint_as_float(w & 0xffff0000u); }
__device__ __forceinline__ float sigmoidf_(float x) { return __builtin_amdgcn_rcpf(1.0f + __builtin_amdgcn_exp2f(-1.4426950408889634f * x)); }

struct EpiProj {
    static constexpr bool PERM = true;
    bf16_t* O0; int ldc0; bf16_t* O1; int ldc1;
    __device__ __forceinline__ void operator()(const f32x4 (&acc)[2][2][4][2], const Unit& u, int wr, int wc, int fr, int fq) const {
        bf16_t* O = u.kind ? O1 : O0; const int ldc = u.kind ? ldc1 : ldc0;
        const int row0 = u.pm * BM + wr * 64 + fr; const int col0 = u.pn * BM + wc * 32 + 8 * fq;
#pragma unroll
        for (int ai = 0; ai < 2; ++ai)
#pragma unroll
            for (int m = 0; m < 4; ++m) { bf16_t* rowp = O + (size_t)(row0 + ai * HALF + m * 16) * ldc + col0;
#pragma unroll
                for (int bj = 0; bj < 2; ++bj) { const f32x4 v0 = acc[ai][bj][m][0], v1 = acc[ai][bj][m][1];
                    u32x4 w; w.x = cvt_pk_bf16(v0[0], v0[1]); w.y = cvt_pk_bf16(v0[2], v0[3]); w.z = cvt_pk_bf16(v1[0], v1[1]); w.w = cvt_pk_bf16(v1[2], v1[3]);
                    *(u32x4*)(rowp + bj * HALF) = w; } }
    }
};
struct BigBuf { float* main; float* tail;
    __device__ __forceinline__ float* tile(int pm) const { return pm < 64 ? main + (size_t)pm * 256 * 2048 : tail; } };
struct BigBufC { const float* main; const float* tail;
    __device__ __forceinline__ const float* tile(int pm) const { return pm < 64 ? main + (size_t)pm * 256 * 2048 : tail; } };

struct EpiGateF32 {
    static constexpr bool PERM = true;
    BigBuf T; const bf16_t* gate; int gld;
    __device__ __forceinline__ void operator()(const f32x4 (&acc)[2][2][4][2], const Unit& u, int wr, int wc, int fr, int fq) const {
        const int rl0 = wr * 64 + fr; const int col0 = u.pn * BM + wc * 32 + 8 * fq; float* tb = T.tile(u.pm);
#pragma unroll
        for (int ai = 0; ai < 2; ++ai)
#pragma unroll
            for (int m = 0; m < 4; ++m) { const int rl = rl0 + ai * HALF + m * 16; const bf16_t* gp = gate + (size_t)(u.pm * BM + rl) * gld + col0; float* tp = tb + (size_t)rl * 2048 + col0;
#pragma unroll
                for (int bj = 0; bj < 2; ++bj) { const u32x4 g = *(const u32x4*)(gp + bj * HALF); const f32x4 v0 = acc[ai][bj][m][0], v1 = acc[ai][bj][m][1];
                    f32x4 o0, o1;
                    o0[0] = sigmoidf_(bf_lo(g.x)) * v0[0]; o0[1] = sigmoidf_(bf_hi(g.x)) * v0[1]; o0[2] = sigmoidf_(bf_lo(g.y)) * v0[2]; o0[3] = sigmoidf_(bf_hi(g.y)) * v0[3];
                    o1[0] = sigmoidf_(bf_lo(g.z)) * v1[0]; o1[1] = sigmoidf_(bf_hi(g.z)) * v1[1]; o1[2] = sigmoidf_(bf_lo(g.w)) * v1[2]; o1[3] = sigmoidf_(bf_hi(g.w)) * v1[3];
                    *(f32x4*)(tp + bj * HALF) = o0; *(f32x4*)(tp + bj * HALF + 4) = o1; }
                if (m & 1) asm volatile("" ::: "memory"); }
    }
};
struct EpiMerge {
    static constexpr bool PERM = true;
    BigBufC T; const bf16_t* gate; int gld; bf16_t* O;
    __device__ __forceinline__ void operator()(const f32x4 (&acc)[2][2][4][2], const Unit& u, int wr, int wc, int fr, int fq) const {
        const int rl0 = wr * 64 + fr; const int col0 = u.pn * BM + wc * 32 + 8 * fq; const float* tb = T.tile(u.pm);
#pragma unroll
        for (int ai = 0; ai < 2; ++ai)
#pragma unroll
            for (int m = 0; m < 4; ++m) { const int rl = rl0 + ai * HALF + m * 16; const size_t grow = (size_t)(u.pm * BM + rl);
                const bf16_t* gp = gate + grow * gld + col0; const float* tp = tb + (size_t)rl * 2048 + col0; bf16_t* op = O + grow * 2048 + col0;
#pragma unroll
                for (int bj = 0; bj < 2; ++bj) { const u32x4 g = *(const u32x4*)(gp + bj * HALF); const f32x4 t0 = *(const f32x4*)(tp + bj * HALF), t1 = *(const f32x4*)(tp + bj * HALF + 4);
                    const f32x4 v0 = acc[ai][bj][m][0], v1 = acc[ai][bj][m][1];
                    f32x4 o0, o1;
                    o0[0] = sigmoidf_(bf_lo(g.x)) * v0[0] + t0[0]; o0[1] = sigmoidf_(bf_hi(g.x)) * v0[1] + t0[1]; o0[2] = sigmoidf_(bf_lo(g.y)) * v0[2] + t0[2]; o0[3] = sigmoidf_(bf_hi(g.y)) * v0[3] + t0[3];
                    o1[0] = sigmoidf_(bf_lo(g.z)) * v1[0] + t1[0]; o1[1] = sigmoidf_(bf_hi(g.z)) * v1[1] + t1[1]; o1[2] = sigmoidf_(bf_lo(g.w)) * v1[2] + t1[2]; o1[3] = sigmoidf_(bf_hi(g.w)) * v1[3] + t1[3];
                    u32x4 w; w.x = cvt_pk_bf16(o0[0], o0[1]); w.y = cvt_pk_bf16(o0[2], o0[3]); w.z = cvt_pk_bf16(o1[0], o1[1]); w.w = cvt_pk_bf16(o1[2], o1[3]);
                    *(u32x4*)(op + bj * HALF) = w; }
                if (m & 1) asm volatile("" ::: "memory"); }
    }
};
struct EpiResid {
    static constexpr bool PERM = true;
    BigBufC X; BigBuf Hh; bf16_t* HB; float* ss;
    __device__ __forceinline__ void operator()(const f32x4 (&acc)[2][2][4][2], const Unit& u, int wr, int wc, int fr, int fq) const {
        const int rl0 = wr * 64 + fr; const int col0 = u.pn * BM + wc * 32 + 8 * fq; const float* xb = X.tile(u.pm); float* hb_ = Hh.tile(u.pm);
#pragma unroll
        for (int ai = 0; ai < 2; ++ai)
#pragma unroll
            for (int m = 0; m < 4; ++m) { const int rl = rl0 + ai * HALF + m * 16; const size_t grow = (size_t)(u.pm * BM + rl);
                const float* xp = xb + (size_t)rl * 2048 + col0; float* hp = hb_ + (size_t)rl * 2048 + col0; bf16_t* op = HB + grow * 2048 + col0; float q = 0.f;
#pragma unroll
                for (int bj = 0; bj < 2; ++bj) { const f32x4 x0 = *(const f32x4*)(xp + bj * HALF), x1 = *(const f32x4*)(xp + bj * HALF + 4);
                    const f32x4 o0 = acc[ai][bj][m][0] + x0, o1 = acc[ai][bj][m][1] + x1;
                    q += (o0[0] * o0[0] + o0[1] * o0[1]) + (o0[2] * o0[2] + o0[3] * o0[3]) + (o1[0] * o1[0] + o1[1] * o1[1]) + (o1[2] * o1[2] + o1[3] * o1[3]);
                    *(f32x4*)(hp + bj * HALF) = o0; *(f32x4*)(hp + bj * HALF + 4) = o1;
                    u32x4 w; w.x = cvt_pk_bf16(o0[0], o0[1]); w.y = cvt_pk_bf16(o0[2], o0[3]); w.z = cvt_pk_bf16(o1[0], o1[1]); w.w = cvt_pk_bf16(o1[2], o1[3]);
                    *(u32x4*)(op + bj * HALF) = w; }
                q += __shfl_xor(q, 16); q += __shfl_xor(q, 32);
                if (fq == 0) atomicAdd(ss + grow, q);
                if (m & 1) asm volatile("" ::: "memory"); }
    }
};
struct EpiUp {
    static constexpr bool PERM = true;
    const float* ss; bf16_t* O;
    __device__ __forceinline__ void operator()(const f32x4 (&acc)[2][2][4][2], const Unit& u, int wr, int wc, int fr, int fq) const {
        const int row0 = u.pm * BM + wr * 64 + fr; const int col0 = u.pn * BM + wc * 32 + 8 * fq;
        float rs[2][4];
#pragma unroll
        for (int ai = 0; ai < 2; ++ai)
#pragma unroll
            for (int m = 0; m < 4; ++m) rs[ai][m] = __builtin_amdgcn_rsqf(ss[row0 + ai * HALF + m * 16] * (1.0f / 2048.0f) + 1e-6f);
#pragma unroll
        for (int ai = 0; ai < 2; ++ai)
#pragma unroll
            for (int m = 0; m < 4; ++m) { bf16_t* rowp = O + (size_t)(row0 + ai * HALF + m * 16) * 8192 + col0; const float r = rs[ai][m];
#pragma unroll
                for (int bj = 0; bj < 2; ++bj) { f32x4 v0 = acc[ai][bj][m][0] * r, v1 = acc[ai][bj][m][1] * r;
#pragma unroll
                    for (int j = 0; j < 4; ++j) { const float a = fmaxf(v0[j], 0.f), b = fmaxf(v1[j], 0.f); v0[j] = a * a; v1[j] = b * b; }
                    u32x4 w; w.x = cvt_pk_bf16(v0[0], v0[1]); w.y = cvt_pk_bf16(v0[2], v0[3]); w.z = cvt_pk_bf16(v1[0], v1[1]); w.w = cvt_pk_bf16(v1[2], v1[3]);
                    *(u32x4*)(rowp + bj * HALF) = w; } }
    }
};
struct EpiDown {
    static constexpr bool PERM = true;
    BigBuf Hh;
    __device__ __forceinline__ void operator()(const f32x4 (&acc)[2][2][4][2], const Unit& u, int wr, int wc, int fr, int fq) const {
        const int rl0 = wr * 64 + fr; const int col0 = u.pn * BM + wc * 32 + 8 * fq; float* hb_ = Hh.tile(u.pm);
#pragma unroll
        for (int ai = 0; ai < 2; ++ai)
#pragma unroll
            for (int m = 0; m < 4; ++m) { const int rl = rl0 + ai * HALF + m * 16; float* hp = hb_ + (size_t)rl * 2048 + col0;
#pragma unroll
                for (int bj = 0; bj < 2; ++bj) { const f32x4 x0 = *(const f32x4*)(hp + bj * HALF), x1 = *(const f32x4*)(hp + bj * HALF + 4);
                    *(f32x4*)(hp + bj * HALF) = acc[ai][bj][m][0] + x0; *(f32x4*)(hp + bj * HALF + 4) = acc[ai][bj][m][1] + x1; }
                if (m & 1) asm volatile("" ::: "memory"); }
    }
};

template <class Epi, class Sched, bool ALIGN_EPI = false, bool SP2 = false>
__device__ __forceinline__ void gemm_phase(PG8_LAS unsigned char* lds, const Gemm g, const Sched& S, const Epi& E) {
    const int tid = threadIdx.x, wid = __builtin_amdgcn_readfirstlane(tid >> 6), lane = tid & 63, wr = wid >> 2, wc = wid & 3, fr = lane & 15, fq = lane >> 4;
    const int K = g.K, nt = K / BK;
    unsigned voffA[2], voffB[2];
#pragma unroll
    for (int i = 0; i < 2; ++i) { int R, C; stage_rc(tid * 16 + i * 8192, R, C); const int Rb = Epi::PERM ? ((R & ~31) + perm32(R & 31)) : R;
        voffA[i] = (unsigned)(R * K + C) * 2u; voffB[i] = (unsigned)(Rb * K + C) * 2u; }
    const size_t kstep = (size_t)(BK * 2);
    const size_t hstep = (size_t)HALF * K * 2;
    const size_t tstep = 2 * hstep;
    const unsigned ldsw = (unsigned)wid * 1024u;
    const int aoff = lds_byte(wr * 64 + fr, fq * 8), boff = lds_byte(wc * 32 + fr, fq * 8);
#define PG8_SA(b, h) (((b) * 2 + (h)) * HTB)
#define PG8_SB(b, h) ((4 + (b) * 2 + (h)) * HTB)
#define PG8_STAGE(bufoff, gbase, voff) do { _Pragma("unroll") for (int _i = 0; _i < 2; ++_i) \
        __builtin_amdgcn_global_load_lds((const unsigned*)((const char*)(gbase) + (voff)[_i]), (PG8_LAS unsigned*)(lds + (bufoff) + ldsw + _i * 8192), 16, 0, 0); } while (0)
#define PG8_LDA(dst, b, h) do { _Pragma("unroll") for (int m = 0; m < 4; ++m) _Pragma("unroll") for (int k = 0; k < 2; ++k) dst[m][k] = *(const PG8_LAS bf16x8*)(lds + PG8_SA(b, h) + aoff + m * 2048 + k * 1024); } while (0)
#define PG8_LDB(dst, b, h) do { _Pragma("unroll") for (int n = 0; n < 2; ++n) _Pragma("unroll") for (int k = 0; k < 2; ++k) dst[n][k] = *(const PG8_LAS bf16x8*)(lds + PG8_SB(b, h) + boff + n * 2048 + k * 1024); } while (0)
#define PG8_MMA(ai, bj, At, Bt) do { __builtin_amdgcn_s_setprio(1); _Pragma("unroll") for (int m = 0; m < 4; ++m) _Pragma("unroll") for (int n = 0; n < 2; ++n) _Pragma("unroll") for (int k = 0; k < 2; ++k) \
        acc[ai][bj][m][n] = __builtin_amdgcn_mfma_f32_16x16x32_bf16(Bt[n][k], At[m][k], acc[ai][bj][m][n], 0, 0, 0); __builtin_amdgcn_s_setprio(0); } while (0)
#define PG8_WAIT_V(n) asm volatile("s_waitcnt vmcnt(" #n ")" ::: "memory")
#define PG8_WAIT_L(n) asm volatile("s_waitcnt lgkmcnt(" #n ")" ::: "memory")
#define PG8_BAR __builtin_amdgcn_s_barrier()
#define PG8_SCHED __builtin_amdgcn_sched_barrier(0)
    Unit cur, nxt; int ui = 0;
    if (!S.next(0, cur)) return;
    f32x4 acc[2][2][4][2];
#pragma unroll
    for (int a = 0; a < 2; ++a)
#pragma unroll
        for (int b = 0; b < 2; ++b)
#pragma unroll
            for (int m = 0; m < 4; ++m)
#pragma unroll
                for (int n = 0; n < 2; ++n) acc[a][b][m][n] = (f32x4){0.f, 0.f, 0.f, 0.f};
    bf16x8 At[4][2], B0[2][2], B1[2][2];
    const char* cA = S.a_tile(g, cur, tstep); const char* cB = S.b_tile(g, cur, tstep);
    S.a_ready(cur);
    if constexpr (SP2) {
        PG8_STAGE(PG8_SB(0, 0), cB, voffB); PG8_STAGE(PG8_SB(0, 1), cB + hstep, voffB); PG8_STAGE(PG8_SA(0, 0), cA, voffA); PG8_STAGE(PG8_SA(0, 1), cA + hstep, voffA);
        if (wr == 1) PG8_BAR;
        PG8_WAIT_V(2); PG8_BAR;
        PG8_STAGE(PG8_SB(1, 0), cB + kstep, voffB); PG8_STAGE(PG8_SA(1, 0), cA + kstep, voffA); PG8_STAGE(PG8_SB(1, 1), cB + hstep + kstep, voffB);
        PG8_WAIT_V(6); PG8_BAR;
    } else {
        PG8_STAGE(PG8_SB(0, 0), cB, voffB); PG8_STAGE(PG8_SA(0, 0), cA, voffA); PG8_STAGE(PG8_SB(0, 1), cB + hstep, voffB); PG8_STAGE(PG8_SA(0, 1), cA + hstep, voffA);
        if (wr == 1) PG8_BAR;
        PG8_WAIT_V(4); PG8_BAR;
        PG8_STAGE(PG8_SB(1, 0), cB + kstep, voffB); PG8_STAGE(PG8_SA(1, 0), cA + kstep, voffA); PG8_STAGE(PG8_SB(1, 1), cB + hstep + kstep, voffB);
        PG8_WAIT_V(6); PG8_BAR;
    }
    for (;;) {
        const bool has_next = S.next(ui + 1, nxt);
        const char* nA = has_next ? S.a_tile(g, nxt, tstep) : cA; const char* nB = has_next ? S.b_tile(g, nxt, tstep) : cB;
        for (int t = 0; t < nt; t += 2) {
            const bool last = (t == nt - 2);
            const char* a1 = cA + (size_t)(t + 1) * kstep;
            const char* a2 = last ? nA : cA + (size_t)(t + 2) * kstep; const char* b2 = last ? nB : cB + (size_t)(t + 2) * kstep;
            const char* a3 = a2 + kstep; const char* b3 = b2 + kstep;
            if (last && has_next) S.a_ready(nxt);
            if constexpr (SP2) {
            PG8_LDB(B0, 0, 0); PG8_LDB(B1, 0, 1); PG8_SCHED; PG8_LDA(At, 0, 0); PG8_STAGE(PG8_SA(1, 1), a1 + hstep, voffA);
            PG8_WAIT_V(8); PG8_WAIT_L(0); PG8_BAR; PG8_MMA(0, 0, At, B0); PG8_MMA(0, 1, At, B1); PG8_BAR; PG8_SCHED;
            PG8_LDA(At, 0, 1); PG8_STAGE(PG8_SB(0, 0), b2, voffB); PG8_STAGE(PG8_SB(0, 1), b2 + hstep, voffB); PG8_STAGE(PG8_SA(0, 0), a2, voffA);
            PG8_WAIT_V(8); PG8_WAIT_L(0); PG8_BAR; PG8_MMA(1, 0, At, B0); PG8_MMA(1, 1, At, B1); PG8_BAR; PG8_SCHED;
            PG8_LDB(B0, 1, 0); PG8_LDB(B1, 1, 1); PG8_SCHED; PG8_LDA(At, 1, 0); PG8_STAGE(PG8_SA(0, 1), a2 + hstep, voffA);
            PG8_WAIT_V(8); PG8_WAIT_L(0); PG8_BAR; PG8_MMA(0, 0, At, B0); PG8_MMA(0, 1, At, B1); PG8_BAR; PG8_SCHED;
            PG8_LDA(At, 1, 1); PG8_STAGE(PG8_SB(1, 0), b3, voffB); PG8_STAGE(PG8_SB(1, 1), b3 + hstep, voffB); PG8_STAGE(PG8_SA(1, 0), a3, voffA);
            PG8_WAIT_V(8); PG8_WAIT_L(0); PG8_BAR; PG8_MMA(1, 0, At, B0); PG8_MMA(1, 1, At, B1); PG8_BAR; PG8_SCHED;
            } else {
            PG8_LDB(B0, 0, 0); PG8_SCHED; PG8_LDA(At, 0, 0); PG8_STAGE(PG8_SA(1, 1), a1 + hstep, voffA);
            PG8_WAIT_L(8); PG8_BAR; PG8_WAIT_L(0); PG8_MMA(0, 0, At, B0); PG8_BAR; PG8_SCHED;
            PG8_LDB(B1, 0, 1); PG8_STAGE(PG8_SB(0, 0), b2, voffB);
            PG8_BAR; PG8_WAIT_L(0); PG8_MMA(0, 1, At, B1); PG8_BAR;
            PG8_LDA(At, 0, 1); PG8_STAGE(PG8_SA(0, 0), a2, voffA);
            PG8_BAR; PG8_WAIT_L(0); PG8_MMA(1, 0, At, B0); PG8_BAR; PG8_SCHED;
            PG8_STAGE(PG8_SB(0, 1), b2 + hstep, voffB);
            PG8_WAIT_V(6); PG8_BAR; PG8_MMA(1, 1, At, B1); PG8_BAR;
            PG8_LDB(B0, 1, 0); PG8_SCHED; PG8_LDA(At, 1, 0); PG8_STAGE(PG8_SA(0, 1), a2 + hstep, voffA);
            PG8_WAIT_L(8); PG8_BAR; PG8_WAIT_L(0); PG8_MMA(0, 0, At, B0); PG8_BAR; PG8_SCHED;
            PG8_LDB(B1, 1, 1); PG8_STAGE(PG8_SB(1, 0), b3, voffB);
            PG8_BAR; PG8_WAIT_L(0); PG8_MMA(0, 1, At, B1); PG8_BAR;
            PG8_LDA(At, 1, 1); PG8_STAGE(PG8_SA(1, 0), a3, voffA);
            PG8_BAR; PG8_WAIT_L(0); PG8_MMA(1, 0, At, B0); PG8_BAR; PG8_SCHED;
            PG8_STAGE(PG8_SB(1, 1), b3 + hstep, voffB);
            PG8_WAIT_V(6); PG8_BAR; PG8_MMA(1, 1, At, B1); PG8_BAR;
            }
        }
        if constexpr (ALIGN_EPI) { if (wr == 0) PG8_BAR; }
        E(acc, cur, wr, wc, fr, fq); S.done(cur);
        if (!has_next) break;
#pragma unroll
        for (int a = 0; a < 2; ++a)
#pragma unroll
            for (int b = 0; b < 2; ++b)
#pragma unroll
                for (int m = 0; m < 4; ++m)
#pragma unroll
                    for (int n = 0; n < 2; ++n) acc[a][b][m][n] = (f32x4){0.f, 0.f, 0.f, 0.f};
        cur = nxt; cA = nA; cB = nB; ++ui;
        if constexpr (ALIGN_EPI) { if (wr == 1) PG8_BAR; }
    }
    PG8_WAIT_V(0);
    if constexpr (!ALIGN_EPI) { if (wr == 0) PG8_BAR; }
    PG8_BAR;
#undef PG8_SA
#undef PG8_SB
#undef PG8_STAGE
#undef PG8_LDA
#undef PG8_LDB
#undef PG8_MMA
#undef PG8_WAIT_V
#undef PG8_WAIT_L
#undef PG8_BAR
#undef PG8_SCHED
}
}

typedef unsigned short bf16;
typedef float f32x4 __attribute__((ext_vector_type(4)));
typedef float f32x16 __attribute__((ext_vector_type(16)));
typedef short bf16x8 __attribute__((ext_vector_type(8)));
typedef unsigned u32x4 __attribute__((ext_vector_type(4)));
typedef unsigned u32x2 __attribute__((ext_vector_type(2)));
#define LAS __attribute__((address_space(3)))
#define DI __device__ __forceinline__

constexpr int DM = 2048, TX = 16384, NMETA = 16, NSAMP = 128, MROWS = 16640;
constexpr int ROW_SAMP = 16384, ROW_META = 16512, ROW_PAD = 16528;
constexpr int LRUW = 1024, INW = 7680, DFF = 8192, NWAVES = 8;
constexpr int C_XB = 0, C_YB = 1024, C_Q = 2048, C_K = 3072, C_V = 3328, C_GL = 3584, C_GA = 5632;
constexpr float RMS_EPS = 1e-6f, LOG2E = 1.4426950408889634f;
constexpr size_t O_Y = 0, O_YS = 33554432, O_MK = 33816576, O_MV = 33820672, O_WK = 33824768, O_WV = 33857536, O_CONV = 33890304, O_H = 33893376,
                 O_WKS = 33894400, O_WVS = 38088704, O_CONVS = 42283008, O_HS = 42676224, O_END = 42807296;
constexpr size_t MiB = 1u << 20;
constexpr size_t WS_WO = 1 * MiB, WS_WUP = 9 * MiB, WS_WDN = 41 * MiB, WS_WLRU = 73 * MiB, WS_WATT = 77 * MiB, WS_WG = 81 * MiB;
constexpr size_t WS_PROJ = 82 * MiB;
constexpr size_t WS_U = 82 * MiB;
constexpr size_t WS_B = 342 * MiB;
constexpr size_t WS_LRUO = WS_B, WS_ATTO = WS_B + (size_t)MROWS * 1024 * 2;
constexpr size_t WS_C = 407 * MiB;
constexpr size_t WS_WIN = WS_C, WS_VT = WS_C + 30 * MiB;
constexpr size_t WS_TAILF = 472 * MiB, WS_XTAIL = 474 * MiB, WS_AGG = 476 * MiB, WS_SS = 479 * MiB, WS_END = 480 * MiB;
constexpr int NCHUNK_SEQ = 257;
constexpr int LDS_BYTES = 147456;

struct Args { const float* in[26]; float* out; unsigned char* ws; int ph_lo, ph_hi; };

DI float bf2f(bf16 x) { return __uint_as_float((unsigned)x << 16); }
DI float bflo(unsigned w) { return __uint_as_float(w << 16); }
DI float bfhi(unsigned w) { return __uint_as_float(w & 0xffff0000u); }
DI unsigned pk2(float lo, float hi) { return pg8::cvt_pk_bf16(lo, hi); }
DI float wave_sum(float v) {
#pragma unroll
    for (int o = 1; o < 64; o <<= 1) v += __shfl_xor(v, o);
    return v;
}
DI float wave_max(float v) {
#pragma unroll
    for (int o = 1; o < 64; o <<= 1) v = fmaxf(v, __shfl_xor(v, o));
    return v;
}
DI float sigm(float x) { return __builtin_amdgcn_rcpf(1.0f + __builtin_amdgcn_exp2f(-LOG2E * x)); }
DI float gelu_tanh(float x) {
    const float y = 0.7978845608028654f * (x + 0.044715f * x * x * x);
    return x * sigm(2.0f * y);
}
DI float neg_expm1(float x) {
    if (x > -0.125f) { float p = 1.0f / 720.0f; p = p * x + 1.0f / 120.0f; p = p * x + 1.0f / 24.0f; p = p * x + 1.0f / 6.0f; p = p * x + 0.5f; p = p * x + 1.0f; return -(p * x); }
    return 1.0f - __builtin_amdgcn_exp2f(LOG2E * x);
}

DI void p0_transpose_item(const float* W, int K, int N, bf16* WT, int row_off, const float* kscale, LAS float* scr, int item, int lane) {
    const int nblk = N / 32, kb = item / nblk, nb = item % nblk, k0 = 64 * kb, n0 = 32 * nb;
#pragma unroll 8
    for (int i = 0; i < 32; ++i) { const int kk = 2 * i + (lane >> 5); float v = W[(size_t)(k0 + kk) * N + n0 + (lane & 31)]; if (kscale) v *= kscale[k0 + kk]; scr[kk * 33 + (lane & 31)] = v; }
    asm volatile("s_waitcnt lgkmcnt(0)" ::: "memory");
    const int c = lane & 7;
#pragma unroll
    for (int j = 0; j < 4; ++j) { const int n = (lane >> 3) + 8 * j; const LAS float* s = scr + (8 * c) * 33 + n;
        u32x4 o; o.x = pk2(s[0 * 33], s[1 * 33]); o.y = pk2(s[2 * 33], s[3 * 33]); o.z = pk2(s[4 * 33], s[5 * 33]); o.w = pk2(s[6 * 33], s[7 * 33]);
        *(u32x4*)(WT + (size_t)(row_off + n0 + n) * K + k0 + 8 * c) = o; }
    asm volatile("s_waitcnt lgkmcnt(0)" ::: "memory");
}
DI void p0_norm_row(const float* xrow, const float* g, bf16* orow, float* xcopy, int lane) {
    f32x4 v[8]; float s = 0.f;
#pragma unroll
    for (int j = 0; j < 8; ++j) { v[j] = xrow ? *((const f32x4*)xrow + lane + 64 * j) : (f32x4){0.f, 0.f, 0.f, 0.f}; s += (v[j].x * v[j].x + v[j].y * v[j].y) + (v[j].z * v[j].z + v[j].w * v[j].w); }
    if (xcopy) {
#pragma unroll
        for (int j = 0; j < 8; ++j) *((f32x4*)xcopy + lane + 64 * j) = v[j]; }
    const float r = __builtin_amdgcn_rsqf(wave_sum(s) * (1.0f / DM) + RMS_EPS);
#pragma unroll
    for (int j = 0; j < 8; ++j) { const f32x4 gg = *((const f32x4*)g + lane + 64 * j); const f32x4 o = v[j] * r * gg;
        u32x2 w; w.x = pk2(o.x, o.y); w.y = pk2(o.z, o.w); *((u32x2*)orow + lane + 64 * j) = w; }
}

DI int crow(int r, int hi) { return (r & 3) + 8 * (r >> 2) + 4 * hi; }
constexpr int KS_STRIDE = 144, VT_STRIDE = 584, ATT_KS = 0, ATT_VT = 288 * KS_STRIDE  , ATT_LDS = ATT_VT + 64 * VT_STRIDE;
DI void attn_unit(LAS unsigned char* lds, const bf16* proj, const bf16* Vt, bf16* atto, const float* sinks, int qb, int g) {
    const int tid = threadIdx.x, lane = tid & 63, r32 = lane & 31, hi = lane >> 5; const int wave = __builtin_amdgcn_readfirstlane(tid >> 6);
    const int tok0 = 128 * (qb - 1);
    for (int i = tid; i < 288 * 8; i += 512) {
        const int kk = i >> 3, ch = i & 7; u32x4 v = (u32x4){0u, 0u, 0u, 0u};
        if (kk < 272) { int row = (kk < 256) ? tok0 + kk : ROW_META + (kk - 256); if (row < 0) row = 0;
            v = *(const u32x4*)(proj + (size_t)row * INW + C_K + g * 64 + ch * 8); }
        *(LAS u32x4*)(lds + ATT_KS + kk * KS_STRIDE + ch * 16) = v;
    }
    for (int i = tid; i < 64 * 36; i += 512) {
        const int d = i / 36, kc = i - d * 36; u32x4 v = (u32x4){0u, 0u, 0u, 0u};
        if (kc < 34) { const int row = (kc < 32) ? tok0 + 8 * kc : ROW_META + 8 * (kc - 32);
            if (row >= 0) v = *(const u32x4*)(Vt + (size_t)(g * 64 + d) * MROWS + row); }
        LAS u32x2* dst = (LAS u32x2*)(lds + ATT_VT + d * VT_STRIDE + kc * 16);
        dst[0] = (u32x2){v.x, v.y}; dst[1] = (u32x2){v.z, v.w};
    }
    __syncthreads();
    constexpr float C1 = 0.125f * LOG2E;
#pragma unroll 1
    for (int tsk = wave; tsk < 16; tsk += 8) {
        const int hh = tsk & 3, sl = tsk >> 2, h = 4 * g + hh;
        const float sl2 = __builtin_amdgcn_exp2f(-0.5f * (float)(h + 1)) * LOG2E;
        const float sink2 = sinks[h] * LOG2E;
        const int tok = 128 * qb + 32 * sl + r32;
        bf16x8 qf[4];
#pragma unroll
        for (int ks = 0; ks < 4; ++ks) qf[ks] = *(const bf16x8*)(proj + (size_t)tok * INW + C_Q + h * 64 + 16 * ks + 8 * hi);
        f32x16 S[6];
#pragma unroll
        for (int t = 0; t < 6; ++t) {
            const int base = (t < 5) ? 32 * (sl + t) : 256;
            f32x16 a = {};
#pragma unroll
            for (int ks = 0; ks < 4; ++ks) { const bf16x8 kf = *(const LAS bf16x8*)(lds + ATT_KS + (base + r32) * KS_STRIDE + (16 * ks + 8 * hi) * 2);
                a = __builtin_amdgcn_mfma_f32_32x32x16_bf16(kf, qf[ks], a, 0, 0, 0); }
            S[t] = a; __builtin_amdgcn_sched_barrier(0);
        }
        int rb = r32 - 4 * hi; asm volatile("" : "+v"(rb));
        const float negb = -sl2 * (float)rb;
        float mx = sink2;
#pragma unroll
        for (int t = 0; t < 6; ++t) {
            const bool tile_dead = (t < 5) && (qb == 0) && (sl + t < 4);
#pragma unroll
            for (int r = 0; r < 16; ++r) {
                const int cc = (r & 3) + 8 * (r >> 2);
                float v; bool ok;
                if (t < 5) { v = fmaf(S[t][r], C1, fmaf(-sl2, (float)(128 - 32 * t - cc), negb));
                             ok = !tile_dead && (t != 0 || rb <= cc) && (t != 4 || cc <= rb); }
                else { v = S[t][r] * C1; ok = (r < 8); }
                v = ok ? v : -1e30f; S[t][r] = v; mx = fmaxf(mx, v);
            }
        }
        mx = fmaxf(mx, __shfl_xor(mx, 32));
        float sum = 0.f;
#pragma unroll
        for (int t = 0; t < 6; ++t)
#pragma unroll
            for (int r = 0; r < 16; ++r) { const float e = __builtin_amdgcn_exp2f(S[t][r] - mx); S[t][r] = e; sum += e; }
        sum += __shfl_xor(sum, 32);
        const float inv = 1.0f / (sum + __builtin_amdgcn_exp2f(sink2 - mx));
        f32x16 O[2]; O[0] = (f32x16){}; O[1] = (f32x16){};
#pragma unroll
        for (int t = 0; t < 6; ++t) {
            const int base = (t < 5) ? 32 * (sl + t) : 256;
#pragma unroll
            for (int ks = 0; ks < 2; ++ks) {
                u32x4 pw; pw.x = pk2(S[t][8 * ks + 0] * inv, S[t][8 * ks + 1] * inv); pw.y = pk2(S[t][8 * ks + 2] * inv, S[t][8 * ks + 3] * inv);
                pw.z = pk2(S[t][8 * ks + 4] * inv, S[t][8 * ks + 5] * inv); pw.w = pk2(S[t][8 * ks + 6] * inv, S[t][8 * ks + 7] * inv);
                const bf16x8 pb = __builtin_bit_cast(bf16x8, pw);
#pragma unroll
                for (int dt = 0; dt < 2; ++dt) {
                    const LAS unsigned char* vp = lds + ATT_VT + (r32 + 32 * dt) * VT_STRIDE + (base + 16 * ks + 4 * hi) * 2;
                    const u32x2 v0 = *(const LAS u32x2*)vp, v1 = *(const LAS u32x2*)(vp + 16);
                    const u32x4 vw = (u32x4){v0.x, v0.y, v1.x, v1.y};
                    O[dt] = __builtin_amdgcn_mfma_f32_32x32x16_bf16(__builtin_bit_cast(bf16x8, vw), pb, O[dt], 0, 0, 0);
                }
                __builtin_amdgcn_sched_barrier(0);
            }
        }
        bf16* op = atto + (size_t)tok * 1024 + h * 64;
#pragma unroll
        for (int dt = 0; dt < 2; ++dt)
#pragma unroll
            for (int gq = 0; gq < 4; ++gq) { u32x2 w; w.x = pk2(O[dt][4 * gq + 0], O[dt][4 * gq + 1]); w.y = pk2(O[dt][4 * gq + 2], O[dt][4 * gq + 3]);
                *(u32x2*)(op + 32 * dt + 8 * gq + 4 * hi) = w; }
    }
    __syncthreads();
}

constexpr int SA_LDS_PER_WAVE = 4096;
DI void sample_attn_task(LAS unsigned char* wlds, const bf16* proj, const float* cmk, const float* cmv, const float* cwk, const float* cwv, const float* sinks,
                         bf16* atto, float* out_wk, float* out_wv, int b, int g, int lane) {
    LAS float* qs = (LAS float*)wlds; LAS float* sc = (LAS float*)(wlds + 1024);
    const size_t row = (size_t)(ROW_SAMP + b);
#pragma unroll
    for (int hh = 0; hh < 4; ++hh) qs[hh * 64 + lane] = bf2f(proj[row * INW + C_Q + (4 * g + hh) * 64 + lane]);
    asm volatile("s_waitcnt lgkmcnt(0)" ::: "memory");
#pragma unroll 1
    for (int rr = 0; rr < 3; ++rr) {
        const int j = lane + 64 * rr;
        float s0 = 0.f, s1 = 0.f, s2 = 0.f, s3 = 0.f;
        if (j < 145) {
            if (j < 144) {
                const float* kp = (j < 16) ? cmk + ((size_t)(b * 16 + j) * 4 + g) * 64 : cwk + ((size_t)(b * 128 + (j - 16)) * 4 + g) * 64;
                float* okp = (j >= 17) ? out_wk + ((size_t)(b * 128 + (j - 17)) * 4 + g) * 64 : nullptr;
#pragma unroll 4
                for (int d4 = 0; d4 < 16; ++d4) { const f32x4 kv = *((const f32x4*)kp + d4);
                    if (okp) *((f32x4*)okp + d4) = kv;
                    const f32x4 q0 = *(const LAS f32x4*)(qs + 0 * 64 + 4 * d4), q1 = *(const LAS f32x4*)(qs + 1 * 64 + 4 * d4), q2 = *(const LAS f32x4*)(qs + 2 * 64 + 4 * d4), q3 = *(const LAS f32x4*)(qs + 3 * 64 + 4 * d4);
                    s0 += q0.x * kv.x + q0.y * kv.y + q0.z * kv.z + q0.w * kv.w; s1 += q1.x * kv.x + q1.y * kv.y + q1.z * kv.z + q1.w * kv.w;
                    s2 += q2.x * kv.x + q2.y * kv.y + q2.z * kv.z + q2.w * kv.w; s3 += q3.x * kv.x + q3.y * kv.y + q3.z * kv.z + q3.w * kv.w; }
            } else {
                const bf16* kp = proj + row * INW + C_K + g * 64; float* okp = out_wk + ((size_t)(b * 128 + 127) * 4 + g) * 64;
#pragma unroll 4
                for (int d4 = 0; d4 < 16; ++d4) { const u32x2 w = *((const u32x2*)kp + d4); const f32x4 kv = (f32x4){bflo(w.x), bfhi(w.x), bflo(w.y), bfhi(w.y)};
                    *((f32x4*)okp + d4) = kv;
                    const f32x4 q0 = *(const LAS f32x4*)(qs + 0 * 64 + 4 * d4), q1 = *(const LAS f32x4*)(qs + 1 * 64 + 4 * d4), q2 = *(const LAS f32x4*)(qs + 2 * 64 + 4 * d4), q3 = *(const LAS f32x4*)(qs + 3 * 64 + 4 * d4);
                    s0 += q0.x * kv.x + q0.y * kv.y + q0.z * kv.z + q0.w * kv.w; s1 += q1.x * kv.x + q1.y * kv.y + q1.z * kv.z + q1.w * kv.w;
                    s2 += q2.x * kv.x + q2.y * kv.y + q2.z * kv.z + q2.w * kv.w; s3 += q3.x * kv.x + q3.y * kv.y + q3.z * kv.z + q3.w * kv.w; }
            }
            const float dist = (j < 16) ? 0.f : (float)(144 - j);
            const float b0 = __builtin_amdgcn_exp2f(-0.5f * (float)(4 * g + 1)), b1 = __builtin_amdgcn_exp2f(-0.5f * (float)(4 * g + 2)), b2 = __builtin_amdgcn_exp2f(-0.5f * (float)(4 * g + 3)), b3 = __builtin_amdgcn_exp2f(-0.5f * (float)(4 * g + 4));
            sc[0 * 160 + j] = s0 * 0.125f - b0 * dist; sc[1 * 160 + j] = s1 * 0.125f - b1 * dist; sc[2 * 160 + j] = s2 * 0.125f - b2 * dist; sc[3 * 160 + j] = s3 * 0.125f - b3 * dist;
        }
    }
    asm volatile("s_waitcnt lgkmcnt(0)" ::: "memory");
#pragma unroll
    for (int hh = 0; hh < 4; ++hh) {
        const float sink = sinks[4 * g + hh];
        float v[3]; float mx = sink;
#pragma unroll
        for (int rr = 0; rr < 3; ++rr) { const int j = lane + 64 * rr; v[rr] = (j < 145) ? sc[hh * 160 + j] : -1e30f; mx = fmaxf(mx, v[rr]); }
        mx = wave_max(mx);
        float sum = 0.f;
#pragma unroll
        for (int rr = 0; rr < 3; ++rr) { v[rr] = __builtin_amdgcn_exp2f((v[rr] - mx) * LOG2E); sum += v[rr]; }
        sum = wave_sum(sum);
        const float inv = 1.0f / (sum + __builtin_amdgcn_exp2f((sink - mx) * LOG2E));
#pragma unroll
        for (int rr = 0; rr < 3; ++rr) { const int j = lane + 64 * rr; if (j < 145) sc[hh * 160 + j] = v[rr] * inv; }
    }
    asm volatile("s_waitcnt lgkmcnt(0)" ::: "memory");
    float o0 = 0.f, o1 = 0.f, o2 = 0.f, o3 = 0.f;
#pragma unroll 4
    for (int j = 0; j < 144; ++j) {
        const float* vp = (j < 16) ? cmv + ((size_t)(b * 16 + j) * 4 + g) * 64 : cwv + ((size_t)(b * 128 + (j - 16)) * 4 + g) * 64;
        const float vv = vp[lane];
        if (j >= 17) out_wv[((size_t)(b * 128 + (j - 17)) * 4 + g) * 64 + lane] = vv;
        o0 += sc[0 * 160 + j] * vv; o1 += sc[1 * 160 + j] * vv; o2 += sc[2 * 160 + j] * vv; o3 += sc[3 * 160 + j] * vv;
    }
    { const float vv = bf2f(proj[row * INW + C_V + g * 64 + lane]);
      out_wv[((size_t)(b * 128 + 127) * 4 + g) * 64 + lane] = vv;
      o0 += sc[0 * 160 + 144] * vv; o1 += sc[1 * 160 + 144] * vv; o2 += sc[2 * 160 + 144] * vv; o3 += sc[3 * 160 + 144] * vv; }
    bf16* op = atto + row * 1024 + (4 * g) * 64 + lane;
    op[0] = (bf16)(pk2(o0, 0.f) & 0xffffu); op[64] = (bf16)(pk2(o1, 0.f) & 0xffffu); op[128] = (bf16)(pk2(o2, 0.f) & 0xffffu); op[192] = (bf16)(pk2(o3, 0.f) & 0xffffu);
    asm volatile("s_waitcnt lgkmcnt(0)" ::: "memory");
}


constexpr int SK_KC = 512, SK_STRIDE = 1040, SK_BUF = 32 * SK_STRIDE;
template <class F> DI void skinny_task(LAS unsigned char* lds, const bf16* A, int lda, const bf16* Wt, int ldw, int n0, int k0, int klen, F epi) {
    const int tid = threadIdx.x, lane = tid & 63, l15 = lane & 15, kq = lane >> 4; const int wave = __builtin_amdgcn_readfirstlane(tid >> 6);
    typedef float f32x4v __attribute__((ext_vector_type(4)));
    const int wcol = tid >> 4, wpart = tid & 15;
    const bf16* wsrc = Wt + (size_t)(n0 + wcol) * ldw + k0 + wpart * 8;
    const bf16* asrc = A + (size_t)(16 * wave + l15) * lda + k0 + 8 * kq;
    const int nch = klen / SK_KC;
    u32x4 wreg[4];
#pragma unroll
    for (int i = 0; i < 4; ++i) wreg[i] = *(const u32x4*)(wsrc + i * 128);
#pragma unroll
    for (int i = 0; i < 4; ++i) *(LAS u32x4*)(lds + wcol * SK_STRIDE + (wpart + 16 * i) * 16) = wreg[i];
    __syncthreads();
    f32x4v acc0 = {0.f, 0.f, 0.f, 0.f}, acc1 = {0.f, 0.f, 0.f, 0.f};
#pragma unroll 1
    for (int c = 0; c < nch; ++c) {
        const bool more = (c + 1 < nch);
        if (more) {
#pragma unroll
            for (int i = 0; i < 4; ++i) wreg[i] = *(const u32x4*)(wsrc + (size_t)(c + 1) * SK_KC + i * 128); }
        bf16x8 af[16];
#pragma unroll
        for (int sI = 0; sI < 16; ++sI) af[sI] = *(const bf16x8*)(asrc + (size_t)c * SK_KC + 32 * sI);
        const LAS unsigned char* wb = lds + (c & 1) * SK_BUF;
#pragma unroll
        for (int sI = 0; sI < 16; ++sI) {
            const bf16x8 b0 = *(const LAS bf16x8*)(wb + l15 * SK_STRIDE + (32 * sI + 8 * kq) * 2);
            const bf16x8 b1 = *(const LAS bf16x8*)(wb + (16 + l15) * SK_STRIDE + (32 * sI + 8 * kq) * 2);
            acc0 = __builtin_amdgcn_mfma_f32_16x16x32_bf16(af[sI], b0, acc0, 0, 0, 0);
            acc1 = __builtin_amdgcn_mfma_f32_16x16x32_bf16(af[sI], b1, acc1, 0, 0, 0);
        }
        if (more) {
#pragma unroll
            for (int i = 0; i < 4; ++i) *(LAS u32x4*)(lds + ((c + 1) & 1) * SK_BUF + wcol * SK_STRIDE + (wpart + 16 * i) * 16) = wreg[i]; }
        __syncthreads();
    }
#pragma unroll
    for (int r = 0; r < 4; ++r) { const int row = 16 * wave + 4 * kq + r; epi(row, n0 + l15, acc0[r]); epi(row, n0 + 16 + l15, acc1[r]); }
}

constexpr int LRU_G = 0;
constexpr int LRU_XCF = 65536;
constexpr int LRU_XCB = 98304;
constexpr int LRU_CARRY = 115712;
constexpr int LRU_LDS = 119808;
struct LruP { const bf16* proj; const bf16* wg; const float* conv_w; const float* conv_b; const float* bgx; const float* bga; const float* aparam;
              const float* state_conv; const float* state_h; float* agg; bf16* lruo; float* out_hs; };
template <int MODE>
DI void lru_unit(LAS unsigned char* lds, const LruP& P, int seqc  , int n, const LAS float* carry) {
    const int tid = threadIdx.x, lane = tid & 63; const int wave = __builtin_amdgcn_readfirstlane(tid >> 6);
    LAS float* G = (LAS float*)(lds + LRU_G); LAS float* XE = G; LAS float* XCF = (LAS float*)(lds + LRU_XCF);
    const int nrows = (MODE != 2 && seqc == 0) ? 16 : 64;
    const int row0 = (MODE == 2) ? ROW_SAMP + 64 * seqc : (seqc == 0 ? ROW_META : 64 * (seqc - 1));
    const int ch = tid & 127, cg = n * 128 + ch;
    if (MODE != 2) {
        for (int i = tid; i < 67 * 128; i += 512) { const int e = i >> 7; int t = e - 3; float v = 0.f;
            if (t < nrows) { int row = -1;
                if (seqc == 0) { if (t >= 0) row = ROW_META + t; }
                else { const int tokn = 64 * (seqc - 1) + t; row = (tokn >= 0) ? tokn : ROW_META + 16 + tokn; }
                if (row >= 0) v = bf2f(P.proj[(size_t)row * INW + C_XB + n * 128 + (i & 127)]); }
            XE[i] = v; }
        __syncthreads();
    }
    { const float w0 = P.conv_w[0 * LRUW + cg], w1 = P.conv_w[1 * LRUW + cg], w2 = P.conv_w[2 * LRUW + cg], w3 = P.conv_w[3 * LRUW + cg], cb = P.conv_b[cg];
      float xc[16];
#pragma unroll
      for (int k = 0; k < 16; ++k) { const int t = (tid >> 7) + 4 * k;
          if (MODE != 2) xc[k] = w0 * XE[(t + 0) * 128 + ch] + w1 * XE[(t + 1) * 128 + ch] + w2 * XE[(t + 2) * 128 + ch] + w3 * XE[(t + 3) * 128 + ch] + cb;
          else { const int b = 64 * seqc + t; const float* scp = P.state_conv + (size_t)b * 3 * LRUW + cg;
                 xc[k] = w0 * scp[0] + w1 * scp[LRUW] + w2 * scp[2 * LRUW] + w3 * bf2f(P.proj[(size_t)(row0 + t) * INW + C_XB + cg]) + cb; } }
      if (MODE != 2) __syncthreads();
#pragma unroll
      for (int k = 0; k < 16; ++k) { const int t = (tid >> 7) + 4 * k; const float v = (t < nrows) ? xc[k] : 0.f; XCF[t * 128 + ch] = v;
          *(LAS bf16*)(lds + LRU_XCB + t * 272 + ch * 2) = (bf16)(pk2(v, 0.f) & 0xffffu); } }
    __syncthreads();
    { const int r32 = lane & 31, hi = lane >> 5;
      f32x16 acc0 = {}, acc1 = {};
      const bf16* wp = P.wg + ((size_t)(n * 256 + 32 * wave + r32)) * 128 + 8 * hi;
#pragma unroll
      for (int ks = 0; ks < 8; ++ks) {
          const bf16x8 bw = *(const bf16x8*)(wp + 16 * ks);
          const bf16x8 a0 = *(const LAS bf16x8*)(lds + LRU_XCB + r32 * 272 + (16 * ks + 8 * hi) * 2);
          const bf16x8 a1 = *(const LAS bf16x8*)(lds + LRU_XCB + (r32 + 32) * 272 + (16 * ks + 8 * hi) * 2);
          acc0 = __builtin_amdgcn_mfma_f32_32x32x16_bf16(a0, bw, acc0, 0, 0, 0);
          acc1 = __builtin_amdgcn_mfma_f32_32x32x16_bf16(a1, bw, acc1, 0, 0, 0);
      }
      const int col = 32 * wave + r32;
      const float bias = (wave < 4) ? P.bgx[n * 128 + col] : P.bga[n * 128 + col - 128];
#pragma unroll
      for (int r = 0; r < 16; ++r) { const int t = crow(r, hi); G[t * 256 + col] = sigm(acc0[r] + bias); G[(t + 32) * 256 + col] = sigm(acc1[r] + bias); }
    }
    __syncthreads();
    { const float ap = P.aparam[cg]; const float ex = __expf(-ap);
      const float sp = (ex < 0.03f) ? ex * (1.0f - ex * (0.5f - ex * (0.333333333f - ex * (0.25f - ex * 0.2f)))) : logf(1.0f + ex);
#pragma unroll
      for (int k = 0; k < 16; ++k) { const int t = (tid >> 7) + 4 * k;
          const float gx = G[t * 256 + ch], ga = G[t * 256 + 128 + ch], xc = XCF[t * 128 + ch];
          const float loga = -8.0f * ga * sp; const float a = __builtin_amdgcn_exp2f(LOG2E * loga); const float bb = sqrtf(neg_expm1(2.0f * loga)) * gx * xc;
          G[t * 256 + ch] = a; G[t * 256 + 128 + ch] = bb; } }
    __syncthreads();
    if (MODE == 0) {
        if (tid < 128) { float h = 0.f, p = 1.f;
            for (int t = 0; t < nrows; ++t) { const float a = G[t * 256 + ch], bb = G[t * 256 + 128 + ch]; h = a * h + bb; p *= a; }
            P.agg[((size_t)seqc * 2 + 0) * LRUW + cg] = p; P.agg[((size_t)seqc * 2 + 1) * LRUW + cg] = h; }
    } else if (MODE == 1) {
        if (tid < 128) { float h = carry[ch];
            for (int t = 0; t < 64; ++t) { const float a = G[t * 256 + ch], bb = G[t * 256 + 128 + ch]; h = a * h + bb; G[t * 256 + ch] = h; } }
        __syncthreads();
    } else {
#pragma unroll
        for (int k = 0; k < 16; ++k) { const int t = (tid >> 7) + 4 * k; const int b = 64 * seqc + t;
            const float h = G[t * 256 + ch] * P.state_h[(size_t)b * LRUW + cg] + G[t * 256 + 128 + ch]; G[t * 256 + ch] = h; P.out_hs[(size_t)b * LRUW + cg] = h; }
        __syncthreads();
    }
    if (MODE != 0) {
        for (int i = tid; i < 64 * 16; i += 512) { const int t = i >> 4, c8 = (i & 15) * 8; const size_t row = (size_t)(row0 + t);
            const u32x4 y = *(const u32x4*)(P.proj + row * INW + C_YB + n * 128 + c8);
            const f32x4 h0 = *(const LAS f32x4*)(G + t * 256 + c8), h1 = *(const LAS f32x4*)(G + t * 256 + c8 + 4);
            u32x4 w; w.x = pk2(gelu_tanh(bflo(y.x)) * h0.x, gelu_tanh(bfhi(y.x)) * h0.y); w.y = pk2(gelu_tanh(bflo(y.y)) * h0.z, gelu_tanh(bfhi(y.y)) * h0.w);
            w.z = pk2(gelu_tanh(bflo(y.z)) * h1.x, gelu_tanh(bfhi(y.z)) * h1.y); w.w = pk2(gelu_tanh(bflo(y.w)) * h1.z, gelu_tanh(bfhi(y.w)) * h1.w);
            *(u32x4*)(P.lruo + row * 1024 + n * 128 + c8) = w; }
    }
    __syncthreads();
}


#define RLX_AGENT __ATOMIC_RELAXED, __HIP_MEMORY_SCOPE_AGENT
#define XB_TMO      128
#define XB_XCNT(j)  (256  + 64 * (j))
#define XB_XSUB(j)  (1280 + 64 * (j))
#define XB_XGEN(j)  (2304 + 64 * (j))
#define XB_TOP      3328
#define XB_TOPGEN   3392
#define XCD_BAR_WORDS 3456
#define XB_SPIN_CAP (1u << 18)
DI unsigned xb_ld(unsigned* p)              { return __hip_atomic_load(p, __ATOMIC_RELAXED, __HIP_MEMORY_SCOPE_AGENT); }
DI unsigned xb_add(unsigned* p, unsigned v) { return __hip_atomic_fetch_add(p, v, __ATOMIC_RELAXED, __HIP_MEMORY_SCOPE_AGENT); }
DI unsigned xb_xcc_id() { return (unsigned)__builtin_amdgcn_s_getreg((3 << 11) | 20) & 0xFu; }
#define XB_SPIN(cond, bar) do { unsigned _sp = 0; while (cond) { __builtin_amdgcn_s_sleep(1); \
    if ((++_sp & 255u) == 0u) { if (xb_ld(&(bar)[XB_TMO])) break; if (_sp > XB_SPIN_CAP) { atomicAdd(&(bar)[XB_TMO], 1u); break; } } } } while (0)
struct XcdBarrier { unsigned* bar; unsigned x; volatile LAS unsigned* st; };
DI XcdBarrier xcd_barrier_post(unsigned* bar, volatile LAS unsigned* st) {
    XcdBarrier b; b.bar = bar; b.x = xb_xcc_id(); b.st = st;
    if (threadIdx.x == 0) (void)xb_add(&bar[XB_XCNT(b.x)], 1u);
    return b;
}
DI void xcd_barrier_complete(unsigned* bar, unsigned x, unsigned& nloc, unsigned& nx) {
    const unsigned Gn = gridDim.x * gridDim.y * gridDim.z;
    unsigned sum, cnt, mine, sp = 0u;
    for (;;) {
        sum = 0u; cnt = 0u; mine = 0u;
#pragma unroll
        for (unsigned j = 0; j < 16; ++j) { const unsigned c = xb_ld(&bar[XB_XCNT(j)]); sum += c; cnt += (c > 0u) ? 1u : 0u; mine = (j == x) ? c : mine; }
        if (sum == Gn) break;
        __builtin_amdgcn_s_sleep(1);
        if ((++sp & 255u) == 0u) { if (xb_ld(&bar[XB_TMO])) break; if (sp > XB_SPIN_CAP) { atomicAdd(&bar[XB_TMO], 1u); break; } }
    }
    nloc = mine > 0u ? mine : 1u; nx = cnt > 0u ? cnt : 1u;
}
DI void xcd_barrier(const XcdBarrier& b) {
    asm volatile("s_waitcnt vmcnt(0)" ::: "memory");
    __syncthreads();
    if (threadIdx.x == 0) {
        unsigned* bar = b.bar;
        __builtin_amdgcn_s_waitcnt(0);
        unsigned nloc = b.st[0], nx = b.st[1];
        if (nloc == 0u) { xcd_barrier_complete(bar, b.x, nloc, nx); b.st[0] = nloc; b.st[1] = nx; }
        const unsigned old = xb_add(&bar[XB_XSUB(b.x)], 1u);
        const unsigned gen = old / nloc;
        if (old + 1u == (gen + 1u) * nloc) {
            __builtin_amdgcn_fence(__ATOMIC_RELEASE, "agent");
            asm volatile("s_waitcnt vmcnt(0)" ::: "memory");
            const unsigned og = xb_add(&bar[XB_TOP], 1u);
            const unsigned tg = og / nx;
            if (og + 1u == (tg + 1u) * nx) xb_add(&bar[XB_TOPGEN], 1u);
            else XB_SPIN(xb_ld(&bar[XB_TOPGEN]) == tg, bar);
            __builtin_amdgcn_fence(__ATOMIC_ACQUIRE, "agent");
            xb_add(&bar[XB_XGEN(b.x)], 1u);
            asm volatile("s_waitcnt vmcnt(0)" ::: "memory");
        } else {
            XB_SPIN(xb_ld(&bar[XB_XGEN(b.x)]) == gen, bar);
            __builtin_amdgcn_fence(__ATOMIC_ACQUIRE, "agent");
            asm volatile("s_waitcnt vmcnt(0)" ::: "memory");
        }
    }
    __syncthreads();
}
constexpr int MISC_OFF = 131072 + 320;
constexpr size_t WS_CTL = 0, CTL_ZERO_BYTES = 65536;
constexpr int CW_BAR = 4096;

__global__ void __launch_bounds__(NWAVES * 64, 2) griffin_fwd(Args args) {
    extern __shared__ __attribute__((aligned(16))) unsigned char lds_raw[];
    LAS unsigned char* lds = (LAS unsigned char*)lds_raw;
    const int tid = threadIdx.x, lane = tid & 63; const int wave = __builtin_amdgcn_readfirstlane(tid >> 6);
#define G ((int)gridDim.x)
#define bx ((int)blockIdx.x)
#define gw (bx * NWAVES + wave)
#define NGW (G * NWAVES)
#define ws (args.ws)
#define out (args.out)
#define x_prompt (args.in[0])
#define x_sample (args.in[1])
#define Wo_t ((bf16*)(ws + WS_WO))
#define Wup_t ((bf16*)(ws + WS_WUP))
#define Wdn_t ((bf16*)(ws + WS_WDN))
#define Wlru_t ((bf16*)(ws + WS_WLRU))
#define Watt_t ((bf16*)(ws + WS_WATT))
#define Wg_t ((bf16*)(ws + WS_WG))
#define Win_t ((bf16*)(ws + WS_WIN))
#define XN ((bf16*)(ws + WS_B))
#define PROJ ((bf16*)(ws + WS_PROJ))
#define VT ((bf16*)(ws + WS_VT))
#define LRUO ((bf16*)(ws + WS_LRUO))
#define ATTO ((bf16*)(ws + WS_ATTO))
#define MERGED ((bf16*)(ws + WS_C))
#define HB ((bf16*)(ws + WS_B))
#define UB ((bf16*)(ws + WS_U))
#define TAILF ((float*)(ws + WS_TAILF))
#define XTAIL ((float*)(ws + WS_XTAIL))
#define AGG ((float*)(ws + WS_AGG))
#define SS ((float*)(ws + WS_SS))
#define PART ((float*)(ws + WS_C))
    const int lo = args.ph_lo, hi_ph = args.ph_hi;
#if MK_N_LAUNCHES == 1 && !defined(ALL_CG_SYNC)
    if (tid < 32) ((LAS unsigned*)(lds + MISC_OFF))[tid] = 0u;
    __syncthreads();
    const XcdBarrier xbar = xcd_barrier_post((unsigned*)(ws + WS_CTL) + CW_BAR, (volatile LAS unsigned*)(lds + MISC_OFF) + 8);
#endif
#ifndef P2_PARTS
#define P2_PARTS 31
#endif
#ifndef PH_MASK
#define PH_MASK 0x1ff
#endif
#define IN(k) (((PH_MASK >> (k)) & 1) && lo <= (k) && (k) < hi_ph)
#if MK_N_LAUNCHES == 1
#if defined(ALL_CG_SYNC)
#define GRID_BAR(k) do { if (IN(k) && IN((k) + 1)) { cg::this_grid().sync(); } } while (0)
#else
#define GRID_BAR(k) do { if (IN(k) && IN((k) + 1)) { if ((k) == 0) cg::this_grid().sync(); else xcd_barrier(xbar); } } while (0)
#endif
#else
#define GRID_BAR(k) do { } while (0)
#endif

    if (IN(0)) {
        LAS float* scr = (LAS float*)(lds + wave * 16384);
        constexpr int I_IN = 32 * 240, I_O = 32 * 64, I_UP = 32 * 256, I_DN = 128 * 64, I_L = 16 * 64, I_G = 128;
        constexpr int NITEMS = I_IN + I_O + I_UP + I_DN + 2 * I_L + I_G;
        for (int it = gw; it < NITEMS; it += NGW) {
            int r = it;
            if (r < I_IN) { p0_transpose_item(args.in[10], DM, INW, Win_t, 0, nullptr, scr, r, lane); continue; } r -= I_IN;
            if (r < I_O) { p0_transpose_item(args.in[21], DM, DM, Wo_t, 0, nullptr, scr, r, lane); continue; } r -= I_O;
            if (r < I_UP) { p0_transpose_item(args.in[23], DM, DFF, Wup_t, 0, args.in[22], scr, r, lane); continue; } r -= I_UP;
            if (r < I_DN) { p0_transpose_item(args.in[24], DFF, DM, Wdn_t, 0, nullptr, scr, r, lane); continue; } r -= I_DN;
            if (r < I_L) { p0_transpose_item(args.in[19], LRUW, DM, Wlru_t, 0, nullptr, scr, r, lane); continue; } r -= I_L;
            if (r < I_L) { p0_transpose_item(args.in[20], LRUW, DM, Watt_t, 0, nullptr, scr, r, lane); continue; } r -= I_L;
            { const int nb = r >> 4, which = (r >> 3) & 1, sub = r & 7;
              p0_transpose_item((which ? args.in[15] : args.in[13]) + (size_t)nb * 128 * 128, 128, 128, Wg_t + (size_t)nb * 256 * 128, which * 128, nullptr, scr, sub, lane); }
        }
        for (int m = gw; m < MROWS; m += NGW) {
            const float* xr = (m < TX) ? x_prompt + (size_t)m * DM : (m < ROW_META) ? x_sample + (size_t)(m - ROW_SAMP) * DM : (m < ROW_PAD) ? args.in[8] + (size_t)(m - ROW_META) * DM : nullptr;
            p0_norm_row(xr, args.in[9], XN + (size_t)m * DM, (m >= TX) ? XTAIL + (size_t)(m - TX) * DM : nullptr, lane);
        }
        for (int i = bx * 512 + tid; i < MROWS; i += G * 512) SS[i] = 0.f;
    }
    GRID_BAR(0);

    if (IN(1)) {
        pg8::Gemm g{XN, Win_t, MROWS, INW, DM};
        pg8::ProjOrder S; S.init(MROWS, INW, G, bx); S.n1 = MROWS / 256; S.vtile = C_V / 256;
        pg8::EpiProj E{PROJ, INW, VT, MROWS};
        pg8::gemm_phase<pg8::EpiProj, pg8::ProjOrder, true, true>(lds, g, S, E);
    }
    GRID_BAR(1);

    if (IN(2)) {
        if (P2_PARTS & 1) for (int u = bx; u < 512; u += G) attn_unit(lds, PROJ, VT, ATTO, args.in[18], u >> 2, u & 3);
        LruP LP{PROJ, Wg_t, args.in[11], args.in[12], args.in[14], args.in[16], args.in[17], args.in[6], args.in[7], AGG, LRUO, out + O_HS};
        if (P2_PARTS & 2) for (int u = bx; u < NCHUNK_SEQ * 8; u += G) lru_unit<0>(lds, LP, u >> 3, u & 7, nullptr);
        if (P2_PARTS & 4) for (int u = bx; u < 16; u += G) lru_unit<2>(lds, LP, u >> 3, u & 7, nullptr);
        if ((P2_PARTS & 8) && gw < 512) sample_attn_task(lds + wave * SA_LDS_PER_WAVE, PROJ, args.in[2], args.in[3], args.in[4], args.in[5], args.in[18], ATTO, out + O_WKS, out + O_WVS, gw >> 2, gw & 3, lane);
        const int gt = bx * 512 + tid, NT = G * 512;
        for (int i = gt; i < 16 * 256; i += NT) { const int r = i >> 8, c = i & 255; out[O_MK + i] = bf2f(PROJ[(size_t)(ROW_META + r) * INW + C_K + c]); out[O_MV + i] = bf2f(PROJ[(size_t)(ROW_META + r) * INW + C_V + c]); }
        for (int i = gt; i < 128 * 256; i += NT) { const int r = i >> 8, c = i & 255; out[O_WK + i] = bf2f(PROJ[(size_t)(TX - 128 + r) * INW + C_K + c]); out[O_WV + i] = bf2f(PROJ[(size_t)(TX - 128 + r) * INW + C_V + c]); }
        for (int i = gt; i < 3 * 1024; i += NT) { const int r = i >> 10, c = i & 1023; out[O_CONV + i] = bf2f(PROJ[(size_t)(TX - 3 + r) * INW + C_XB + c]); }
        for (int i = gt; i < 128 * 3 * 1024; i += NT) { const int b = i / 3072, r = (i / 1024) % 3, c = i & 1023;
            out[O_CONVS + i] = (r < 2) ? args.in[6][((size_t)b * 3 + r + 1) * LRUW + c] : bf2f(PROJ[(size_t)(ROW_SAMP + b) * INW + C_XB + c]); }
        for (int i = gt; i < 128 * 128; i += NT) { const int row = ROW_META + (i >> 7), c8 = (i & 127) * 8;
            *(u32x4*)(ATTO + (size_t)row * 1024 + c8) = (u32x4){0u, 0u, 0u, 0u}; *(u32x4*)(LRUO + (size_t)row * 1024 + c8) = (u32x4){0u, 0u, 0u, 0u}; }
    }
    GRID_BAR(2);

    if (IN(3)) {
        LruP LP{PROJ, Wg_t, args.in[11], args.in[12], args.in[14], args.in[16], args.in[17], args.in[6], args.in[7], AGG, LRUO, out + O_HS};
        const int n = bx & 7, cb = bx >> 3, cstep = G >> 3;
        LAS float* carry = (LAS float*)(lds + LRU_CARRY);
        if (tid < 128) { float h = 0.f; int nextc = cb, slot = 0;
            for (int k = 0; k < NCHUNK_SEQ; ++k) {
                if (k == nextc + 1) { if (slot < 8) carry[slot * 128 + tid] = h; ++slot; nextc += cstep; }
                const float a = AGG[((size_t)k * 2 + 0) * LRUW + n * 128 + tid], bb = AGG[((size_t)k * 2 + 1) * LRUW + n * 128 + tid]; h = a * h + bb; }
            if (cb == 0) out[O_H + n * 128 + tid] = h; }
        __syncthreads();
        { int slot = 0; for (int c = cb; c < 256; c += cstep, ++slot) lru_unit<1>(lds, LP, c + 1, n, carry + slot * 128); }
        for (int t = bx; t < 64; t += G)
            skinny_task(lds, ATTO + (size_t)ROW_SAMP * 1024, 1024, Watt_t, 1024, 32 * t, 0, 1024, [&](int row, int col, float v) {
                TAILF[(size_t)row * DM + col] = sigm(bf2f(PROJ[(size_t)(ROW_SAMP + row) * INW + C_GA + col])) * v; });
        pg8::Gemm g{ATTO, Watt_t, TX, DM, 1024}; pg8::StaticOrder S; S.init(TX, DM, G, bx);
        pg8::EpiGateF32 E{pg8::BigBuf{out + O_Y, TAILF}, PROJ + C_GA, INW};
        pg8::gemm_phase<pg8::EpiGateF32, pg8::StaticOrder, true, true>(lds, g, S, E);
    }
    GRID_BAR(3);

    if (IN(4)) {
        for (int t = bx; t < 64; t += G)
            skinny_task(lds, LRUO + (size_t)ROW_SAMP * 1024, 1024, Wlru_t, 1024, 32 * t, 0, 1024, [&](int row, int col, float v) {
                const float o = sigm(bf2f(PROJ[(size_t)(ROW_SAMP + row) * INW + C_GL + col])) * v + TAILF[(size_t)row * DM + col];
                MERGED[(size_t)(ROW_SAMP + row) * DM + col] = (bf16)(pk2(o, 0.f) & 0xffffu); });
        pg8::Gemm g{LRUO, Wlru_t, TX, DM, 1024}; pg8::StaticOrder S; S.init(TX, DM, G, bx);
        pg8::EpiMerge E{pg8::BigBufC{out + O_Y, TAILF}, PROJ + C_GL, INW, MERGED};
        pg8::gemm_phase<pg8::EpiMerge, pg8::StaticOrder, true, true>(lds, g, S, E);
    }
    GRID_BAR(4);

    if (IN(5)) {
        for (int t = bx; t < 64; t += G)
            skinny_task(lds, MERGED + (size_t)ROW_SAMP * DM, DM, Wo_t, DM, 32 * t, 0, DM, [&](int row, int col, float v) {
                const float h = XTAIL[(size_t)row * DM + col] + v;
                TAILF[(size_t)row * DM + col] = h; HB[(size_t)(ROW_SAMP + row) * DM + col] = (bf16)(pk2(h, 0.f) & 0xffffu);
                float q = h * h; q += __shfl_xor(q, 1); q += __shfl_xor(q, 2); q += __shfl_xor(q, 4); q += __shfl_xor(q, 8);
                if ((threadIdx.x & 15) == 0) atomicAdd(SS + ROW_SAMP + row, q); });
        pg8::Gemm g{MERGED, Wo_t, TX, DM, DM}; pg8::StaticOrder S; S.init(TX, DM, G, bx);
        pg8::EpiResid E{pg8::BigBufC{x_prompt, XTAIL}, pg8::BigBuf{out + O_Y, TAILF}, HB, SS};
        pg8::gemm_phase<pg8::EpiResid, pg8::StaticOrder, true, true>(lds, g, S, E);
    }
    GRID_BAR(5);

    if (IN(6)) {
        for (int t = bx; t < 256; t += G)
            skinny_task(lds, HB + (size_t)ROW_SAMP * DM, DM, Wup_t, DM, 32 * t, 0, DM, [&](int row, int col, float v) {
                const float a = fmaxf(v * __builtin_amdgcn_rsqf(SS[ROW_SAMP + row] * (1.0f / DM) + RMS_EPS), 0.f);
                UB[(size_t)(ROW_SAMP + row) * DFF + col] = (bf16)(pk2(a * a, 0.f) & 0xffffu); });
        pg8::Gemm g{HB, Wup_t, TX, DFF, DM}; pg8::StaticOrder S; S.init(TX, DFF, G, bx);
        pg8::EpiUp E{SS, UB};
        pg8::gemm_phase<pg8::EpiUp, pg8::StaticOrder, true, true>(lds, g, S, E);
    }
    GRID_BAR(6);

    if (IN(7)) {
        for (int t = bx; t < 256; t += G) { const int ksp = t >> 6;
            skinny_task(lds, UB + (size_t)ROW_SAMP * DFF, DFF, Wdn_t, DFF, 32 * (t & 63), 2048 * ksp, 2048, [&](int row, int col, float v) {
                PART[((size_t)ksp * 128 + row) * DM + col] = v; }); }
        pg8::Gemm g{UB, Wdn_t, TX, DM, DFF}; pg8::StaticOrder S; S.init(TX, DM, G, bx);
        pg8::EpiDown E{pg8::BigBuf{out + O_Y, TAILF}};
        pg8::gemm_phase<pg8::EpiDown, pg8::StaticOrder, true, true>(lds, g, S, E);
    }
    GRID_BAR(7);

    if (IN(8)) {
        const float* gf = args.in[25];
        for (int m = gw; m < TX + NSAMP; m += NGW) {
            const bool smp = (m >= TX);
            const float* src = smp ? TAILF + (size_t)(m - TX) * DM : out + O_Y + (size_t)m * DM;
            float* dst = smp ? out + O_YS + (size_t)(m - TX) * DM : out + O_Y + (size_t)m * DM;
            f32x4 v[8]; float s = 0.f;
#pragma unroll
            for (int j = 0; j < 8; ++j) { v[j] = *((const f32x4*)src + lane + 64 * j);
                if (smp) {
#pragma unroll
                    for (int ks = 0; ks < 4; ++ks) v[j] += *((const f32x4*)(PART + ((size_t)ks * 128 + (m - TX)) * DM) + lane + 64 * j); }
                s += (v[j].x * v[j].x + v[j].y * v[j].y) + (v[j].z * v[j].z + v[j].w * v[j].w); }
            const float r = __builtin_amdgcn_rsqf(wave_sum(s) * (1.0f / DM) + RMS_EPS);
#pragma unroll
            for (int j = 0; j < 8; ++j) { const f32x4 gg = *((const f32x4*)gf + lane + 64 * j); *((f32x4*)dst + lane + 64 * j) = v[j] * r * gg; }
        }
    }
#undef IN
#undef GRID_BAR
#undef G
#undef bx
#undef gw
#undef NGW
#undef ws
#undef out
#undef x_prompt
#undef x_sample
}

extern "C" void kernel_launch(void* const* d_in, const int* in_sizes, int n_in, void* d_out, int out_size, void* d_ws, size_t ws_size, hipStream_t stream) {
    static int grid = 0;
    if (grid == 0) {
        if (n_in != 26 || (size_t)out_size != O_END || ws_size < WS_END) { fprintf(stderr, "kernel_launch: unexpected shapes (n_in %d, out %d, ws %zu)\n", n_in, out_size, ws_size); grid = -1; return; }
        int dev = 0, cus = 0, per_cu = 0;
        if (hipGetDevice(&dev) != hipSuccess || hipDeviceGetAttribute(&cus, hipDeviceAttributeMultiprocessorCount, dev) != hipSuccess) { grid = -1; return; }
        if (hipFuncSetAttribute((const void*)griffin_fwd, hipFuncAttributeMaxDynamicSharedMemorySize, LDS_BYTES) != hipSuccess) { fprintf(stderr, "kernel_launch: hipFuncSetAttribute failed\n"); grid = -1; return; }
        if (hipOccupancyMaxActiveBlocksPerMultiprocessor(&per_cu, (const void*)griffin_fwd, NWAVES * 64, LDS_BYTES) != hipSuccess || per_cu < 1) { fprintf(stderr, "kernel_launch: occupancy query says %d\n", per_cu); (void)hipGetLastError(); grid = -1; return; }
        grid = cus;
        if (grid % 8 != 0 || grid > 256) { fprintf(stderr, "kernel_launch: unexpected CU count %d\n", cus); if (grid > 256) grid = 256; }
    }
    if (grid < 0) return;
    Args a{};
    for (int i = 0; i < 26; ++i) a.in[i] = (const float*)d_in[i];
    a.out = (float*)d_out; a.ws = (unsigned char*)d_ws;
    if (MK_N_LAUNCHES == 1) {
        a.ph_lo = 0; a.ph_hi = N_PHASES;
        if (hipMemsetAsync((char*)d_ws + WS_CTL, 0, CTL_ZERO_BYTES, stream) != hipSuccess) { fprintf(stderr, "kernel_launch: hipMemsetAsync failed\n"); return; }
        void* kargs[] = {&a};
        hipError_t e = hipLaunchCooperativeKernel((const void*)griffin_fwd, dim3(grid), dim3(NWAVES * 64), kargs, LDS_BYTES, stream);
        if (e != hipSuccess) fprintf(stderr, "kernel_launch: cooperative launch failed: %s (grid %d)\n", hipGetErrorString(e), grid);
    } else {
        for (int p = 0; p < N_PHASES; ++p) { a.ph_lo = p; a.ph_hi = p + 1; hipLaunchKernelGGL(griffin_fwd, dim3(grid), dim3(NWAVES * 64), LDS_BYTES, stream, a); }
    }
}
```

```cpp
#include <hip/hip_runtime.h>
#include <hip/hip_cooperative_groups.h>
#include <cstdio>
#include <cstdint>
namespace cg = cooperative_groups;

#ifndef MK_N_LAUNCHES
#define MK_N_LAUNCHES 1
#endif
constexpr int N_PHASES = 9;

namespace pg8 {
#define PG8_LAS __attribute__((address_space(3)))
typedef unsigned short bf16_t;
typedef short bf16x8 __attribute__((ext_vector_type(8)));
typedef float f32x4 __attribute__((ext_vector_type(4)));
typedef unsigned u32x4 __attribute__((ext_vector_type(4)));
constexpr int BM = 256, BK = 64, HALF = 128, HTB = HALF * BK * 2, STAGE_BYTES = 8 * HTB, NXCD = 8, WGM = 8;

__host__ __device__ __forceinline__ int lds_byte(int r, int c) { const int st = (r >> 4) * 2 + (c >> 5), rr = r & 15, cc = c & 31, ob = rr * 64 + cc * 2; return st * 1024 + (ob ^ (((ob >> 9) & 1) << 5)); }
__host__ __device__ __forceinline__ void stage_rc(int b, int& R, int& C) { const int st = b / 1024, sb = b % 1024, swz = sb ^ (((sb >> 9) & 1) << 5); R = (st >> 1) * 16 + swz / 64; C = (st & 1) * 32 + (swz % 64) / 2; }
__host__ __device__ __forceinline__ int perm32(int rho) { const int n = rho >> 4, i = rho & 15; return 8 * (i >> 2) + 4 * n + (i & 3); }

struct Unit { int pm, pn, kind; };
struct Gemm { const bf16_t* A; const bf16_t* Bt; int M, N, K; };

struct StaticOrder {
    int nM, nN, nwg, G, c;
    __host__ __device__ void init(int M, int N, int G_, int c_) { nM = M / BM; nN = N / BM; nwg = nM * nN; G = G_; c = c_; }
    __host__ __device__ bool next(int i, Unit& u) const {
        const long L = (long)i * G + c; if (L >= nwg) return false;
        int wgid = (int)L; { const int q = nwg / NXCD, r = nwg % NXCD, xcd = wgid % NXCD, off = wgid / NXCD; wgid = (xcd < r ? xcd * (q + 1) : r * (q + 1) + (xcd - r) * q) + off; }
        const int nig = WGM * nN, gid = wgid / nig, fm = gid * WGM, gsz = (nM - fm) < WGM ? (nM - fm) : WGM;
        u.pm = fm + ((wgid % nig) % gsz); u.pn = (wgid % nig) / gsz; u.kind = 0; return true;
    }
    __device__ __forceinline__ const char* a_tile(const Gemm& g, const Unit& u, size_t tstep) const { return (const char*)g.A + (size_t)u.pm * tstep; }
    __device__ __forceinline__ const char* b_tile(const Gemm& g, const Unit& u, size_t tstep) const { return (const char*)g.Bt + (size_t)u.pn * tstep; }
    __device__ __forceinline__ void a_ready(const Unit&) const {}
    __device__ __forceinline__ void done(const Unit&) const {}
};
struct ProjOrder : StaticOrder {
    int n1, vtile;
    __host__ __device__ bool next(int i, Unit& u) const {
        const long L = (long)i * G + c; if (L < nwg) return StaticOrder::next(i, u);
        if (L >= nwg + n1) return false;
        u.pm = 0; u.pn = (int)(L - nwg); u.kind = 1; return true;
    }
    __device__ __forceinline__ const char* a_tile(const Gemm& g, const Unit& u, size_t tstep) const { return u.kind ? (const char*)g.Bt + (size_t)vtile * tstep : (const char*)g.A + (size_t)u.pm * tstep; }
    __device__ __forceinline__ const char* b_tile(const Gemm& g, const Unit& u, size_t tstep) const { return u.kind ? (const char*)g.A + (size_t)u.pn * tstep : (const char*)g.Bt + (size_t)u.pn * tstep; }
};

typedef float f32x2_t __attribute__((ext_vector_type(2))); typedef __bf16 bf16x2_t __attribute__((ext_vector_type(2)));
__device__ __forceinline__ unsigned cvt_pk_bf16(float lo, float hi) { f32x2_t v = {lo, hi}; bf16x2_t b = __builtin_convertvector(v, bf16x2_t); return __builtin_bit_cast(unsigned, b); }
__device__ __forceinline__ float bf_lo(unsigned w) { return __uint_as_float(w << 16); }
__device__ __forceinline__ float bf_hi(unsigned w) { return __uint_as_float(w & 0xffff0000u); }
__device__ __forceinline__ float sigmoidf_(float x) { return __builtin_amdgcn_rcpf(1.0f + __builtin_amdgcn_exp2f(-1.4426950408889634f * x)); }

struct EpiProj {
    static constexpr bool PERM = true;
    bf16_t* O0; int ldc0; bf16_t* O1; int ldc1;
    __device__ __forceinline__ void operator()(const f32x4 (&acc)[2][2][4][2], const Unit& u, int wr, int wc, int fr, int fq) const {
        bf16_t* O = u.kind ? O1 : O0; const int ldc = u.kind ? ldc1 : ldc0;
        const int row0 = u.pm * BM + wr * 64 + fr; const int col0 = u.pn * BM + wc * 32 + 8 * fq;
#pragma unroll
        for (int ai = 0; ai < 2; ++ai)
#pragma unroll
            for (int m = 0; m < 4; ++m) { bf16_t* rowp = O + (size_t)(row0 + ai * HALF + m * 16) * ldc + col0;
#pragma unroll
                for (int bj = 0; bj < 2; ++bj) { const f32x4 v0 = acc[ai][bj][m][0], v1 = acc[ai][bj][m][1];
                    u32x4 w; w.x = cvt_pk_bf16(v0[0], v0[1]); w.y = cvt_pk_bf16(v0[2], v0[3]); w.z = cvt_pk_bf16(v1[0], v1[1]); w.w = cvt_pk_bf16(v1[2], v1[3]);
                    *(u32x4*)(rowp + bj * HALF) = w; } }
    }
};
struct BigBuf { float* main; float* tail;
    __device__ __forceinline__ float* tile(int pm) const { return pm < 64 ? main + (size_t)pm * 256 * 2048 : tail; } };
struct BigBufC { const float* main; const float* tail;
    __device__ __forceinline__ const float* tile(int pm) const { return pm < 64 ? main + (size_t)pm * 256 * 2048 : tail; } };

struct EpiGateF32 {
    static constexpr bool PERM = true;
    BigBuf T; const bf16_t* gate; int gld;
    __device__ __forceinline__ void operator()(const f32x4 (&acc)[2][2][4][2], const Unit& u, int wr, int wc, int fr, int fq) const {
        const int rl0 = wr * 64 + fr; const int col0 = u.pn * BM + wc * 32 + 8 * fq; float* tb = T.tile(u.pm);
#pragma unroll
        for (int ai = 0; ai < 2; ++ai)
#pragma unroll
            for (int m = 0; m < 4; ++m) { const int rl = rl0 + ai * HALF + m * 16; const bf16_t* gp = gate + (size_t)(u.pm * BM + rl) * gld + col0; float* tp = tb + (size_t)rl * 2048 + col0;
#pragma unroll
                for (int bj = 0; bj < 2; ++bj) { const u32x4 g = *(const u32x4*)(gp + bj * HALF); const f32x4 v0 = acc[ai][bj][m][0], v1 = acc[ai][bj][m][1];
                    f32x4 o0, o1;
                    o0[0] = sigmoidf_(bf_lo(g.x)) * v0[0]; o0[1] = sigmoidf_(bf_hi(g.x)) * v0[1]; o0[2] = sigmoidf_(bf_lo(g.y)) * v0[2]; o0[3] = sigmoidf_(bf_hi(g.y)) * v0[3];
                    o1[0] = sigmoidf_(bf_lo(g.z)) * v1[0]; o1[1] = sigmoidf_(bf_hi(g.z)) * v1[1]; o1[2] = sigmoidf_(bf_lo(g.w)) * v1[2]; o1[3] = sigmoidf_(bf_hi(g.w)) * v1[3];
                    *(f32x4*)(tp + bj * HALF) = o0; *(f32x4*)(tp + bj * HALF + 4) = o1; }
                asm volatile("" ::: "memory"); }
    }
};
struct EpiMerge {
    static constexpr bool PERM = true;
    BigBufC T; const bf16_t* gate; int gld; bf16_t* O;
    __device__ __forceinline__ void operator()(const f32x4 (&acc)[2][2][4][2], const Unit& u, int wr, int wc, int fr, int fq) const {
        const int rl0 = wr * 64 + fr; const int col0 = u.pn * BM + wc * 32 + 8 * fq; const float* tb = T.tile(u.pm);
#pragma unroll
        for (int ai = 0; ai < 2; ++ai)
#pragma unroll
            for (int m = 0; m < 4; ++m) { const int rl = rl0 + ai * HALF + m * 16; const size_t grow = (size_t)(u.pm * BM + rl);
                const bf16_t* gp = gate + grow * gld + col0; const float* tp = tb + (size_t)rl * 2048 + col0; bf16_t* op = O + grow * 2048 + col0;
#pragma unroll
                for (int bj = 0; bj < 2; ++bj) { const u32x4 g = *(const u32x4*)(gp + bj * HALF); const f32x4 t0 = *(const f32x4*)(tp + bj * HALF), t1 = *(const f32x4*)(tp + bj * HALF + 4);
                    const f32x4 v0 = acc[ai][bj][m][0], v1 = acc[ai][bj][m][1];
                    f32x4 o0, o1;
                    o0[0] = sigmoidf_(bf_lo(g.x)) * v0[0] + t0[0]; o0[1] = sigmoidf_(bf_hi(g.x)) * v0[1] + t0[1]; o0[2] = sigmoidf_(bf_lo(g.y)) * v0[2] + t0[2]; o0[3] = sigmoidf_(bf_hi(g.y)) * v0[3] + t0[3];
                    o1[0] = sigmoidf_(bf_lo(g.z)) * v1[0] + t1[0]; o1[1] = sigmoidf_(bf_hi(g.z)) * v1[1] + t1[1]; o1[2] = sigmoidf_(bf_lo(g.w)) * v1[2] + t1[2]; o1[3] = sigmoidf_(bf_hi(g.w)) * v1[3] + t1[3];
                    u32x4 w; w.x = cvt_pk_bf16(o0[0], o0[1]); w.y = cvt_pk_bf16(o0[2], o0[3]); w.z = cvt_pk_bf16(o1[0], o1[1]); w.w = cvt_pk_bf16(o1[2], o1[3]);
                    *(u32x4*)(op + bj * HALF) = w; }
                asm volatile("" ::: "memory"); }
    }
};
struct EpiResid {
    static constexpr bool PERM = true;
    BigBufC X; BigBuf Hh; bf16_t* HB; float* ss;
    __device__ __forceinline__ void operator()(const f32x4 (&acc)[2][2][4][2], const Unit& u, int wr, int wc, int fr, int fq) const {
        const int rl0 = wr * 64 + fr; const int col0 = u.pn * BM + wc * 32 + 8 * fq; const float* xb = X.tile(u.pm); float* hb_ = Hh.tile(u.pm);
#pragma unroll
        for (int ai = 0; ai < 2; ++ai)
#pragma unroll
            for (int m = 0; m < 4; ++m) { const int rl = rl0 + ai * HALF + m * 16; const size_t grow = (size_t)(u.pm * BM + rl);
                const float* xp = xb + (size_t)rl * 2048 + col0; float* hp = hb_ + (size_t)rl * 2048 + col0; bf16_t* op = HB + grow * 2048 + col0; float q = 0.f;
#pragma unroll
                for (int bj = 0; bj < 2; ++bj) { const f32x4 x0 = *(const f32x4*)(xp + bj * HALF), x1 = *(const f32x4*)(xp + bj * HALF + 4);
                    const f32x4 o0 = acc[ai][bj][m][0] + x0, o1 = acc[ai][bj][m][1] + x1;
                    q += (o0[0] * o0[0] + o0[1] * o0[1]) + (o0[2] * o0[2] + o0[3] * o0[3]) + (o1[0] * o1[0] + o1[1] * o1[1]) + (o1[2] * o1[2] + o1[3] * o1[3]);
                    *(f32x4*)(hp + bj * HALF) = o0; *(f32x4*)(hp + bj * HALF + 4) = o1;
                    u32x4 w; w.x = cvt_pk_bf16(o0[0], o0[1]); w.y = cvt_pk_bf16(o0[2], o0[3]); w.z = cvt_pk_bf16(o1[0], o1[1]); w.w = cvt_pk_bf16(o1[2], o1[3]);
                    *(u32x4*)(op + bj * HALF) = w; }
                q += __shfl_xor(q, 16); q += __shfl_xor(q, 32);
                if (fq == 0) atomicAdd(ss + grow, q);
                asm volatile("" ::: "memory"); }
    }
};
struct EpiUp {
    static constexpr bool PERM = true;
    const float* ss; bf16_t* O;
    __device__ __forceinline__ void operator()(const f32x4 (&acc)[2][2][4][2], const Unit& u, int wr, int wc, int fr, int fq) const {
        const int row0 = u.pm * BM + wr * 64 + fr; const int col0 = u.pn * BM + wc * 32 + 8 * fq;
        float rs[2][4];
#pragma unroll
        for (int ai = 0; ai < 2; ++ai)
#pragma unroll
            for (int m = 0; m < 4; ++m) rs[ai][m] = __builtin_amdgcn_rsqf(ss[row0 + ai * HALF + m * 16] * (1.0f / 2048.0f) + 1e-6f);
#pragma unroll
        for (int ai = 0; ai < 2; ++ai)
#pragma unroll
            for (int m = 0; m < 4; ++m) { bf16_t* rowp = O + (size_t)(row0 + ai * HALF + m * 16) * 8192 + col0; const float r = rs[ai][m];
#pragma unroll
                for (int bj = 0; bj < 2; ++bj) { f32x4 v0 = acc[ai][bj][m][0] * r, v1 = acc[ai][bj][m][1] * r;
#pragma unroll
                    for (int j = 0; j < 4; ++j) { const float a = fmaxf(v0[j], 0.f), b = fmaxf(v1[j], 0.f); v0[j] = a * a; v1[j] = b * b; }
                    u32x4 w; w.x = cvt_pk_bf16(v0[0], v0[1]); w.y = cvt_pk_bf16(v0[2], v0[3]); w.z = cvt_pk_bf16(v1[0], v1[1]); w.w = cvt_pk_bf16(v1[2], v1[3]);
                    *(u32x4*)(rowp + bj * HALF) = w; } }
    }
};
struct EpiDown {
    static constexpr bool PERM = true;
    BigBuf Hh;
    __device__ __forceinline__ void operator()(const f32x4 (&acc)[2][2][4][2], const Unit& u, int wr, int wc, int fr, int fq) const {
        const int rl0 = wr * 64 + fr; const int col0 = u.pn * BM + wc * 32 + 8 * fq; float* hb_ = Hh.tile(u.pm);
#pragma unroll
        for (int ai = 0; ai < 2; ++ai)
#pragma unroll
            for (int m = 0; m < 4; ++m) { const int rl = rl0 + ai * HALF + m * 16; float* hp = hb_ + (size_t)rl * 2048 + col0;
#pragma unroll
                for (int bj = 0; bj < 2; ++bj) { const f32x4 x0 = *(const f32x4*)(hp + bj * HALF), x1 = *(const f32x4*)(hp + bj * HALF + 4);
                    *(f32x4*)(hp + bj * HALF) = acc[ai][bj][m][0] + x0; *(f32x4*)(hp + bj * HALF + 4) = acc[ai][bj][m][1] + x1; }
                asm volatile("" ::: "memory"); }
    }
};

template <class Epi, class Sched, bool ALIGN_EPI = false, bool SP2 = false>
__device__ __forceinline__ void gemm_phase(PG8_LAS unsigned char* lds, const Gemm g, const Sched& S, const Epi& E) {
    const int tid = threadIdx.x, wid = __builtin_amdgcn_readfirstlane(tid >> 6), lane = tid & 63, wr = wid >> 2, wc = wid & 3, fr = lane & 15, fq = lane >> 4;
    const int K = g.K, nt = K / BK;
    unsigned voffA[2], voffB[2];
#pragma unroll
    for (int i = 0; i < 2; ++i) { int R, C; stage_rc(tid * 16 + i * 8192, R, C); const int Rb = Epi::PERM ? ((R & ~31) + perm32(R & 31)) : R;
        voffA[i] = (unsigned)(R * K + C) * 2u; voffB[i] = (unsigned)(Rb * K + C) * 2u; }
    const size_t kstep = (size_t)(BK * 2);
    const size_t hstep = (size_t)HALF * K * 2;
    const size_t tstep = 2 * hstep;
    const unsigned ldsw = (unsigned)wid * 1024u;
    const int aoff = lds_byte(wr * 64 + fr, fq * 8), boff = lds_byte(wc * 32 + fr, fq * 8);
#define PG8_SA(b, h) (((b) * 2 + (h)) * HTB)
#define PG8_SB(b, h) ((4 + (b) * 2 + (h)) * HTB)
#define PG8_STAGE(bufoff, gbase, voff) do { _Pragma("unroll") for (int _i = 0; _i < 2; ++_i) \
        __builtin_amdgcn_global_load_lds((const unsigned*)((const char*)(gbase) + (voff)[_i]), (PG8_LAS unsigned*)(lds + (bufoff) + ldsw + _i * 8192), 16, 0, 0); } while (0)
#define PG8_LDA(dst, b, h) do { _Pragma("unroll") for (int m = 0; m < 4; ++m) _Pragma("unroll") for (int k = 0; k < 2; ++k) dst[m][k] = *(const PG8_LAS bf16x8*)(lds + PG8_SA(b, h) + aoff + m * 2048 + k * 1024); } while (0)
#define PG8_LDB(dst, b, h) do { _Pragma("unroll") for (int n = 0; n < 2; ++n) _Pragma("unroll") for (int k = 0; k < 2; ++k) dst[n][k] = *(const PG8_LAS bf16x8*)(lds + PG8_SB(b, h) + boff + n * 2048 + k * 1024); } while (0)
#define PG8_MMA(ai, bj, At, Bt) do { __builtin_amdgcn_s_setprio(1); _Pragma("unroll") for (int m = 0; m < 4; ++m) _Pragma("unroll") for (int n = 0; n < 2; ++n) _Pragma("unroll") for (int k = 0; k < 2; ++k) \
        acc[ai][bj][m][n] = __builtin_amdgcn_mfma_f32_16x16x32_bf16(Bt[n][k], At[m][k], acc[ai][bj][m][n], 0, 0, 0); __builtin_amdgcn_s_setprio(0); } while (0)
#define PG8_WAIT_V(n) asm volatile("s_waitcnt vmcnt(" #n ")" ::: "memory")
#define PG8_WAIT_L(n) asm volatile("s_waitcnt lgkmcnt(" #n ")" ::: "memory")
#define PG8_BAR __builtin_amdgcn_s_barrier()
#define PG8_SCHED __builtin_amdgcn_sched_barrier(0)
    Unit cur, nxt; int ui = 0;
    if (!S.next(0, cur)) return;
    f32x4 acc[2][2][4][2];
#pragma unroll
    for (int a = 0; a < 2; ++a)
#pragma unroll
        for (int b = 0; b < 2; ++b)
#pragma unroll
            for (int m = 0; m < 4; ++m)
#pragma unroll
                for (int n = 0; n < 2; ++n) acc[a][b][m][n] = (f32x4){0.f, 0.f, 0.f, 0.f};
    bf16x8 At[4][2], B0[2][2], B1[2][2];
    const char* cA = S.a_tile(g, cur, tstep); const char* cB = S.b_tile(g, cur, tstep);
    S.a_ready(cur);
    if constexpr (SP2) {
        PG8_STAGE(PG8_SB(0, 0), cB, voffB); PG8_STAGE(PG8_SB(0, 1), cB + hstep, voffB); PG8_STAGE(PG8_SA(0, 0), cA, voffA); PG8_STAGE(PG8_SA(0, 1), cA + hstep, voffA);
        if (wr == 1) PG8_BAR;
        PG8_WAIT_V(2); PG8_BAR;
        PG8_STAGE(PG8_SB(1, 0), cB + kstep, voffB); PG8_STAGE(PG8_SA(1, 0), cA + kstep, voffA); PG8_STAGE(PG8_SB(1, 1), cB + hstep + kstep, voffB);
        PG8_WAIT_V(6); PG8_BAR;
    } else {
        PG8_STAGE(PG8_SB(0, 0), cB, voffB); PG8_STAGE(PG8_SA(0, 0), cA, voffA); PG8_STAGE(PG8_SB(0, 1), cB + hstep, voffB); PG8_STAGE(PG8_SA(0, 1), cA + hstep, voffA);
        if (wr == 1) PG8_BAR;
        PG8_WAIT_V(4); PG8_BAR;
        PG8_STAGE(PG8_SB(1, 0), cB + kstep, voffB); PG8_STAGE(PG8_SA(1, 0), cA + kstep, voffA); PG8_STAGE(PG8_SB(1, 1), cB + hstep + kstep, voffB);
        PG8_WAIT_V(6); PG8_BAR;
    }
    for (;;) {
        const bool has_next = S.next(ui + 1, nxt);
        const char* nA = has_next ? S.a_tile(g, nxt, tstep) : cA; const char* nB = has_next ? S.b_tile(g, nxt, tstep) : cB;
        for (int t = 0; t < nt; t += 2) {
            const bool last = (t == nt - 2);
            const char* a1 = cA + (size_t)(t + 1) * kstep;
            const char* a2 = last ? nA : cA + (size_t)(t + 2) * kstep; const char* b2 = last ? nB : cB + (size_t)(t + 2) * kstep;
            const char* a3 = a2 + kstep; const char* b3 = b2 + kstep;
            if (last && has_next) S.a_ready(nxt);
            if constexpr (SP2) {
            PG8_LDB(B0, 0, 0); PG8_LDB(B1, 0, 1); PG8_SCHED; PG8_LDA(At, 0, 0); PG8_STAGE(PG8_SA(1, 1), a1 + hstep, voffA);
            PG8_WAIT_V(8); PG8_WAIT_L(0); PG8_BAR; PG8_MMA(0, 0, At, B0); PG8_MMA(0, 1, At, B1); PG8_BAR; PG8_SCHED;
            PG8_LDA(At, 0, 1); PG8_STAGE(PG8_SB(0, 0), b2, voffB); PG8_STAGE(PG8_SB(0, 1), b2 + hstep, voffB); PG8_STAGE(PG8_SA(0, 0), a2, voffA);
            PG8_WAIT_V(8); PG8_WAIT_L(0); PG8_BAR; PG8_MMA(1, 0, At, B0); PG8_MMA(1, 1, At, B1); PG8_BAR; PG8_SCHED;
            PG8_LDB(B0, 1, 0); PG8_LDB(B1, 1, 1); PG8_SCHED; PG8_LDA(At, 1, 0); PG8_STAGE(PG8_SA(0, 1), a2 + hstep, voffA);
            PG8_WAIT_V(8); PG8_WAIT_L(0); PG8_BAR; PG8_MMA(0, 0, At, B0); PG8_MMA(0, 1, At, B1); PG8_BAR; PG8_SCHED;
            PG8_LDA(At, 1, 1); PG8_STAGE(PG8_SB(1, 0), b3, voffB); PG8_STAGE(PG8_SB(1, 1), b3 + hstep, voffB); PG8_STAGE(PG8_SA(1, 0), a3, voffA);
            PG8_WAIT_V(8); PG8_WAIT_L(0); PG8_BAR; PG8_MMA(1, 0, At, B0); PG8_MMA(1, 1, At, B1); PG8_BAR; PG8_SCHED;
            } else {
            PG8_LDB(B0, 0, 0); PG8_SCHED; PG8_LDA(At, 0, 0); PG8_STAGE(PG8_SA(1, 1), a1 + hstep, voffA);
            PG8_WAIT_L(8); PG8_BAR; PG8_WAIT_L(0); PG8_MMA(0, 0, At, B0); PG8_BAR; PG8_SCHED;
            PG8_LDB(B1, 0, 1); PG8_STAGE(PG8_SB(0, 0), b2, voffB);
            PG8_BAR; PG8_WAIT_L(0); PG8_MMA(0, 1, At, B1); PG8_BAR;
            PG8_LDA(At, 0, 1); PG8_STAGE(PG8_SA(0, 0), a2, voffA);
            PG8_BAR; PG8_WAIT_L(0); PG8_MMA(1, 0, At, B0); PG8_BAR; PG8_SCHED;
            PG8_STAGE(PG8_SB(0, 1), b2 + hstep, voffB);
            PG8_WAIT_V(6); PG8_BAR; PG8_MMA(1, 1, At, B1); PG8_BAR;
            PG8_LDB(B0, 1, 0); PG8_SCHED; PG8_LDA(At, 1, 0); PG8_STAGE(PG8_SA(0, 1), a2 + hstep, voffA);
            PG8_WAIT_L(8); PG8_BAR; PG8_WAIT_L(0); PG8_MMA(0, 0, At, B0); PG8_BAR; PG8_SCHED;
            PG8_LDB(B1, 1, 1); PG8_STAGE(PG8_SB(1, 0), b3, voffB);
            PG8_BAR; PG8_WAIT_L(0); PG8_MMA(0, 1, At, B1); PG8_BAR;
            PG8_LDA(At, 1, 1); PG8_STAGE(PG8_SA(1, 0), a3, voffA);
            PG8_BAR; PG8_WAIT_L(0); PG8_MMA(1, 0, At, B0); PG8_BAR; PG8_SCHED;
            PG8_STAGE(PG8_SB(1, 1), b3 + hstep, voffB);
            PG8_WAIT_V(6); PG8_BAR; PG8_MMA(1, 1, At, B1); PG8_BAR;
            }
        }
        if constexpr (ALIGN_EPI) { if (wr == 0) PG8_BAR; }
        E(acc, cur, wr, wc, fr, fq); S.done(cur);
        if (!has_next) break;
#pragma unroll
        for (int a = 0; a < 2; ++a)
#pragma unroll
            for (int b = 0; b < 2; ++b)
#pragma unroll
                for (int m = 0; m < 4; ++m)
#pragma unroll
                    for (int n = 0; n < 2; ++n) acc[a][b][m][n] = (f32x4){0.f, 0.f, 0.f, 0.f};
        cur = nxt; cA = nA; cB = nB; ++ui;
        if constexpr (ALIGN_EPI) { if (wr == 1) PG8_BAR; }
    }
    PG8_WAIT_V(0);
    if constexpr (!ALIGN_EPI) { if (wr == 0) PG8_BAR; }
    PG8_BAR;
#undef PG8_SA
#undef PG8_SB
#undef PG8_STAGE
#undef PG8_LDA
#undef PG8_LDB
#undef PG8_MMA
#undef PG8_WAIT_V
#undef PG8_WAIT_L
#undef PG8_BAR
#undef PG8_SCHED
}
}

typedef unsigned short bf16;
typedef float f32x4 __attribute__((ext_vector_type(4)));
typedef float f32x16 __attribute__((ext_vector_type(16)));
typedef short bf16x8 __attribute__((ext_vector_type(8)));
typedef unsigned u32x4 __attribute__((ext_vector_type(4)));
typedef unsigned u32x2 __attribute__((ext_vector_type(2)));
#define LAS __attribute__((address_space(3)))
#define DI __device__ __forceinline__

constexpr int DM = 2048, TX = 16384, NMETA = 16, NSAMP = 128, MROWS = 16640;
constexpr int ROW_SAMP = 16384, ROW_META = 16512, ROW_PAD = 16528;
constexpr int LRUW = 1024, INW = 7680, DFF = 8192, NWAVES = 8;
constexpr int C_XB = 0, C_YB = 1024, C_Q = 2048, C_K = 3072, C_V = 3328, C_GL = 3584, C_GA = 5632;
constexpr float RMS_EPS = 1e-6f, LOG2E = 1.4426950408889634f;
constexpr size_t O_Y = 0, O_YS = 33554432, O_MK = 33816576, O_MV = 33820672, O_WK = 33824768, O_WV = 33857536, O_CONV = 33890304, O_H = 33893376,
                 O_WKS = 33894400, O_WVS = 38088704, O_CONVS = 42283008, O_HS = 42676224, O_END = 42807296;
constexpr size_t MiB = 1u << 20;
constexpr size_t WS_WO = 1 * MiB, WS_WUP = 9 * MiB, WS_WDN = 41 * MiB, WS_WLRU = 73 * MiB, WS_WATT = 77 * MiB, WS_WG = 81 * MiB;
constexpr size_t WS_PROJ = 82 * MiB;
constexpr size_t WS_U = 82 * MiB;
constexpr size_t WS_B = 342 * MiB;
constexpr size_t WS_LRUO = WS_B, WS_ATTO = WS_B + (size_t)MROWS * 1024 * 2;
constexpr size_t WS_C = 407 * MiB;
constexpr size_t WS_WIN = WS_C, WS_VT = WS_C + 30 * MiB;
constexpr size_t WS_TAILF = 472 * MiB, WS_XTAIL = 474 * MiB, WS_AGG = 476 * MiB, WS_SS = 479 * MiB, WS_END = 480 * MiB;
constexpr int NCHUNK_SEQ = 257;
constexpr int LDS_BYTES = 147456;

struct Args { const float* in[26]; float* out; unsigned char* ws; int ph_lo, ph_hi; };

DI float bf2f(bf16 x) { return __uint_as_float((unsigned)x << 16); }
DI float bflo(unsigned w) { return __uint_as_float(w << 16); }
DI float bfhi(unsigned w) { return __uint_as_float(w & 0xffff0000u); }
DI unsigned pk2(float lo, float hi) { return pg8::cvt_pk_bf16(lo, hi); }
DI float wave_sum(float v) {
#pragma unroll
    for (int o = 1; o < 64; o <<= 1) v += __shfl_xor(v, o);
    return v;
}
DI float wave_max(float v) {
#pragma unroll
    for (int o = 1; o < 64; o <<= 1) v = fmaxf(v, __shfl_xor(v, o));
    return v;
}
DI float sigm(float x) { return __builtin_amdgcn_rcpf(1.0f + __builtin_amdgcn_exp2f(-LOG2E * x)); }
DI float gelu_tanh(float x) {
    const float y = 0.7978845608028654f * (x + 0.044715f * x * x * x);
    return x * sigm(2.0f * y);
}
DI float neg_expm1(float x) {
    if (x > -0.125f) { float p = 1.0f / 720.0f; p = p * x + 1.0f / 120.0f; p = p * x + 1.0f / 24.0f; p = p * x + 1.0f / 6.0f; p = p * x + 0.5f; p = p * x + 1.0f; return -(p * x); }
    return 1.0f - __builtin_amdgcn_exp2f(LOG2E * x);
}

DI void p0_transpose_item(const float* W, int K, int N, bf16* WT, int row_off, const float* kscale, LAS float* scr, int item, int lane) {
    const int nblk = N / 32, kb = item / nblk, nb = item % nblk, k0 = 64 * kb, n0 = 32 * nb;
#pragma unroll 8
    for (int i = 0; i < 32; ++i) { const int kk = 2 * i + (lane >> 5); float v = W[(size_t)(k0 + kk) * N + n0 + (lane & 31)]; if (kscale) v *= kscale[k0 + kk]; scr[kk * 33 + (lane & 31)] = v; }
    asm volatile("s_waitcnt lgkmcnt(0)" ::: "memory");
    const int c = lane & 7;
#pragma unroll
    for (int j = 0; j < 4; ++j) { const int n = (lane >> 3) + 8 * j; const LAS float* s = scr + (8 * c) * 33 + n;
        u32x4 o; o.x = pk2(s[0 * 33], s[1 * 33]); o.y = pk2(s[2 * 33], s[3 * 33]); o.z = pk2(s[4 * 33], s[5 * 33]); o.w = pk2(s[6 * 33], s[7 * 33]);
        *(u32x4*)(WT + (size_t)(row_off + n0 + n) * K + k0 + 8 * c) = o; }
    asm volatile("s_waitcnt lgkmcnt(0)" ::: "memory");
}
DI void p0_norm_row(const float* xrow, const float* g, bf16* orow, float* xcopy, int lane) {
    f32x4 v[8]; float s = 0.f;
#pragma unroll
    for (int j = 0; j < 8; ++j) { v[j] = xrow ? *((const f32x4*)xrow + lane + 64 * j) : (f32x4){0.f, 0.f, 0.f, 0.f}; s += (v[j].x * v[j].x + v[j].y * v[j].y) + (v[j].z * v[j].z + v[j].w * v[j].w); }
    if (xcopy) {
#pragma unroll
        for (int j = 0; j < 8; ++j) *((f32x4*)xcopy + lane + 64 * j) = v[j]; }
    const float r = __builtin_amdgcn_rsqf(wave_sum(s) * (1.0f / DM) + RMS_EPS);
#pragma unroll
    for (int j = 0; j < 8; ++j) { const f32x4 gg = *((const f32x4*)g + lane + 64 * j); const f32x4 o = v[j] * r * gg;
        u32x2 w; w.x = pk2(o.x, o.y); w.y = pk2(o.z, o.w); *((u32x2*)orow + lane + 64 * j) = w; }
}

DI int crow(int r, int hi) { return (r & 3) + 8 * (r >> 2) + 4 * hi; }
constexpr int KS_STRIDE = 144, VT_STRIDE = 584, ATT_KS = 0, ATT_VT = 288 * KS_STRIDE  , ATT_LDS = ATT_VT + 64 * VT_STRIDE;
DI void attn_unit(LAS unsigned char* lds, const bf16* proj, const bf16* Vt, bf16* atto, const float* sinks, int qb, int g) {
    const int tid = threadIdx.x, lane = tid & 63, r32 = lane & 31, hi = lane >> 5; const int wave = __builtin_amdgcn_readfirstlane(tid >> 6);
    const int tok0 = 128 * (qb - 1);
    for (int i = tid; i < 288 * 8; i += 512) {
        const int kk = i >> 3, ch = i & 7; u32x4 v = (u32x4){0u, 0u, 0u, 0u};
        if (kk < 272) { int row = (kk < 256) ? tok0 + kk : ROW_META + (kk - 256); if (row < 0) row = 0;
            v = *(const u32x4*)(proj + (size_t)row * INW + C_K + g * 64 + ch * 8); }
        *(LAS u32x4*)(lds + ATT_KS + kk * KS_STRIDE + ch * 16) = v;
    }
    for (int i = tid; i < 64 * 36; i += 512) {
        const int d = i / 36, kc = i - d * 36; u32x4 v = (u32x4){0u, 0u, 0u, 0u};
        if (kc < 34) { const int row = (kc < 32) ? tok0 + 8 * kc : ROW_META + 8 * (kc - 32);
            if (row >= 0) v = *(const u32x4*)(Vt + (size_t)(g * 64 + d) * MROWS + row); }
        LAS u32x2* dst = (LAS u32x2*)(lds + ATT_VT + d * VT_STRIDE + kc * 16);
        dst[0] = (u32x2){v.x, v.y}; dst[1] = (u32x2){v.z, v.w};
    }
    __syncthreads();
    constexpr float C1 = 0.125f * LOG2E;
#pragma unroll 1
    for (int tsk = wave; tsk < 16; tsk += 8) {
        const int hh = tsk & 3, sl = tsk >> 2, h = 4 * g + hh;
        const float sl2 = __builtin_amdgcn_exp2f(-0.5f * (float)(h + 1)) * LOG2E;
        const float sink2 = sinks[h] * LOG2E;
        const int tok = 128 * qb + 32 * sl + r32;
        bf16x8 qf[4];
#pragma unroll
        for (int ks = 0; ks < 4; ++ks) qf[ks] = *(const bf16x8*)(proj + (size_t)tok * INW + C_Q + h * 64 + 16 * ks + 8 * hi);
        f32x16 S[6];
#pragma unroll
        for (int t = 0; t < 6; ++t) {
            const int base = (t < 5) ? 32 * (sl + t) : 256;
            f32x16 a = {};
#pragma unroll
            for (int ks = 0; ks < 4; ++ks) { const bf16x8 kf = *(const LAS bf16x8*)(lds + ATT_KS + (base + r32) * KS_STRIDE + (16 * ks + 8 * hi) * 2);
                a = __builtin_amdgcn_mfma_f32_32x32x16_bf16(kf, qf[ks], a, 0, 0, 0); }
            S[t] = a; __builtin_amdgcn_sched_barrier(0);
        }
        int rb = r32 - 4 * hi; asm volatile("" : "+v"(rb));
        const float negb = -sl2 * (float)rb;
        float mx = sink2;
#pragma unroll
        for (int t = 0; t < 6; ++t) {
            const bool tile_dead = (t < 5) && (qb == 0) && (sl + t < 4);
#pragma unroll
            for (int r = 0; r < 16; ++r) {
                const int cc = (r & 3) + 8 * (r >> 2);
                float v; bool ok;
                if (t < 5) { v = fmaf(S[t][r], C1, fmaf(-sl2, (float)(128 - 32 * t - cc), negb));
                             ok = !tile_dead && (t != 0 || rb <= cc) && (t != 4 || cc <= rb); }
                else { v = S[t][r] * C1; ok = (r < 8); }
                v = ok ? v : -1e30f; S[t][r] = v; mx = fmaxf(mx, v);
            }
        }
        mx = fmaxf(mx, __shfl_xor(mx, 32));
        float sum = 0.f;
#pragma unroll
        for (int t = 0; t < 6; ++t)
#pragma unroll
            for (int r = 0; r < 16; ++r) { const float e = __builtin_amdgcn_exp2f(S[t][r] - mx); S[t][r] = e; sum += e; }
        sum += __shfl_xor(sum, 32);
        const float inv = 1.0f / (sum + __builtin_amdgcn_exp2f(sink2 - mx));
        f32x16 O[2]; O[0] = (f32x16){}; O[1] = (f32x16){};
#pragma unroll
        for (int t = 0; t < 6; ++t) {
            const int base = (t < 5) ? 32 * (sl + t) : 256;
#pragma unroll
            for (int ks = 0; ks < 2; ++ks) {
                u32x4 pw; pw.x = pk2(S[t][8 * ks + 0] * inv, S[t][8 * ks + 1] * inv); pw.y = pk2(S[t][8 * ks + 2] * inv, S[t][8 * ks + 3] * inv);
                pw.z = pk2(S[t][8 * ks + 4] * inv, S[t][8 * ks + 5] * inv); pw.w = pk2(S[t][8 * ks + 6] * inv, S[t][8 * ks + 7] * inv);
                const bf16x8 pb = __builtin_bit_cast(bf16x8, pw);
#pragma unroll
                for (int dt = 0; dt < 2; ++dt) {
                    const LAS unsigned char* vp = lds + ATT_VT + (r32 + 32 * dt) * VT_STRIDE + (base + 16 * ks + 4 * hi) * 2;
                    const u32x2 v0 = *(const LAS u32x2*)vp, v1 = *(const LAS u32x2*)(vp + 16);
                    const u32x4 vw = (u32x4){v0.x, v0.y, v1.x, v1.y};
                    O[dt] = __builtin_amdgcn_mfma_f32_32x32x16_bf16(__builtin_bit_cast(bf16x8, vw), pb, O[dt], 0, 0, 0);
                }
                __builtin_amdgcn_sched_barrier(0);
            }
        }
        bf16* op = atto + (size_t)tok * 1024 + h * 64;
#pragma unroll
        for (int dt = 0; dt < 2; ++dt)
#pragma unroll
            for (int gq = 0; gq < 4; ++gq) { u32x2 w; w.x = pk2(O[dt][4 * gq + 0], O[dt][4 * gq + 1]); w.y = pk2(O[dt][4 * gq + 2], O[dt][4 * gq + 3]);
                *(u32x2*)(op + 32 * dt + 8 * gq + 4 * hi) = w; }
    }
    __syncthreads();
}

constexpr int SA_HALF = 24576, SA_SC = 1024, SA_RED = 4096;
DI void sample_attn_item(LAS unsigned char* lds, const bf16* proj, const float* cmk, const float* cmv, const float* cwk, const float* cwv, const float* sinks,
                         bf16* atto, float* out_wk, float* out_wv, int b, int gp) {
    const int tid = threadIdx.x, th = tid & 255, lane = tid & 63; const int half = __builtin_amdgcn_readfirstlane(tid >> 8);
    const int g = 2 * gp + half;
    LAS unsigned char* hl = lds + half * SA_HALF;
    LAS float* qs = (LAS float*)hl; LAS float* sc = (LAS float*)(hl + SA_SC); LAS float* red = (LAS float*)(hl + SA_RED);
    const size_t row = (size_t)(ROW_SAMP + b);
    { const int hh = th >> 6, d = th & 63; qs[hh * 64 + d] = bf2f(proj[row * INW + C_Q + (4 * g + hh) * 64 + d]); }
    __syncthreads();
    const int d4 = th & 15, jg = th >> 4;
    float sl[4];
#pragma unroll
    for (int hh = 0; hh < 4; ++hh) sl[hh] = __builtin_amdgcn_exp2f(-0.5f * (float)(4 * g + hh + 1));
    {
        f32x4 kv[9];
#pragma unroll
        for (int m = 0; m < 9; ++m) { const int j = jg + 16 * m;
            const float* kp = (j < 16) ? cmk + ((size_t)(b * 16 + j) * 4 + g) * 64 : cwk + ((size_t)(b * 128 + (j - 16)) * 4 + g) * 64;
            kv[m] = *((const f32x4*)kp + d4); }
        f32x4 qv[4];
#pragma unroll
        for (int hh = 0; hh < 4; ++hh) qv[hh] = *(const LAS f32x4*)(qs + hh * 64 + 4 * d4);
#pragma unroll
        for (int m = 0; m < 9; ++m) { const int j = jg + 16 * m;
            if (j >= 17) *((f32x4*)(out_wk + ((size_t)(b * 128 + (j - 17)) * 4 + g) * 64) + d4) = kv[m];
            const float dist = (j < 16) ? 0.f : (float)(144 - j);
#pragma unroll
            for (int hh = 0; hh < 4; ++hh) { float sdot = qv[hh].x * kv[m].x + qv[hh].y * kv[m].y + qv[hh].z * kv[m].z + qv[hh].w * kv[m].w;
                sdot += __shfl_xor(sdot, 1); sdot += __shfl_xor(sdot, 2); sdot += __shfl_xor(sdot, 4); sdot += __shfl_xor(sdot, 8);
                if (d4 == 0) sc[hh * 160 + j] = sdot * 0.125f - sl[hh] * dist; } }
        const u32x2 w = *((const u32x2*)(proj + row * INW + C_K + g * 64) + d4); const f32x4 kn = (f32x4){bflo(w.x), bfhi(w.x), bflo(w.y), bfhi(w.y)};
        if (th < 16) *((f32x4*)(out_wk + ((size_t)(b * 128 + 127) * 4 + g) * 64) + d4) = kn;
#pragma unroll
        for (int hh = 0; hh < 4; ++hh) { float sdot = qv[hh].x * kn.x + qv[hh].y * kn.y + qv[hh].z * kn.z + qv[hh].w * kn.w;
            sdot += __shfl_xor(sdot, 1); sdot += __shfl_xor(sdot, 2); sdot += __shfl_xor(sdot, 4); sdot += __shfl_xor(sdot, 8);
            if (th == 0) sc[hh * 160 + 144] = sdot * 0.125f; }
    }
    __syncthreads();
    {
        const int hh = th >> 6; const float sink = sinks[4 * g + hh];
        float v[3]; float mx = sink;
#pragma unroll
        for (int rr = 0; rr < 3; ++rr) { const int j = lane + 64 * rr; v[rr] = (j < 145) ? sc[hh * 160 + j] : -1e30f; mx = fmaxf(mx, v[rr]); }
        mx = wave_max(mx);
        float sum = 0.f;
#pragma unroll
        for (int rr = 0; rr < 3; ++rr) { v[rr] = __builtin_amdgcn_exp2f((v[rr] - mx) * LOG2E); sum += v[rr]; }
        sum = wave_sum(sum);
        const float inv = 1.0f / (sum + __builtin_amdgcn_exp2f((sink - mx) * LOG2E));
#pragma unroll
        for (int rr = 0; rr < 3; ++rr) { const int j = lane + 64 * rr; if (j < 145) sc[hh * 160 + j] = v[rr] * inv; }
    }
    __syncthreads();
    {
        f32x4 vv[9];
#pragma unroll
        for (int m = 0; m < 9; ++m) { const int j = jg + 16 * m;
            const float* vp = (j < 16) ? cmv + ((size_t)(b * 16 + j) * 4 + g) * 64 : cwv + ((size_t)(b * 128 + (j - 16)) * 4 + g) * 64;
            vv[m] = *((const f32x4*)vp + d4); }
        f32x4 o[4]; o[0] = o[1] = o[2] = o[3] = (f32x4){0.f, 0.f, 0.f, 0.f};
#pragma unroll
        for (int m = 0; m < 9; ++m) { const int j = jg + 16 * m;
            if (j >= 17) *((f32x4*)(out_wv + ((size_t)(b * 128 + (j - 17)) * 4 + g) * 64) + d4) = vv[m];
#pragma unroll
            for (int hh = 0; hh < 4; ++hh) o[hh] += vv[m] * sc[hh * 160 + j]; }
        if (th < 16) { const u32x2 w = *((const u32x2*)(proj + row * INW + C_V + g * 64) + d4); const f32x4 vn = (f32x4){bflo(w.x), bfhi(w.x), bflo(w.y), bfhi(w.y)};
            *((f32x4*)(out_wv + ((size_t)(b * 128 + 127) * 4 + g) * 64) + d4) = vn;
#pragma unroll
            for (int hh = 0; hh < 4; ++hh) o[hh] += vn * sc[hh * 160 + 144]; }
#pragma unroll
        for (int hh = 0; hh < 4; ++hh) *(LAS f32x4*)(red + (jg * 16 + d4) * 16 + hh * 4) = o[hh];
    }
    __syncthreads();
    { const int hh = th >> 6, d = th & 63; float acc = 0.f;
#pragma unroll
      for (int grp = 0; grp < 16; ++grp) acc += red[(grp * 16 + (d >> 2)) * 16 + hh * 4 + (d & 3)];
      atto[row * 1024 + (4 * g + hh) * 64 + d] = (bf16)(pk2(acc, 0.f) & 0xffffu); }
    __syncthreads();
}

constexpr int SK_KC = 512, SK_STRIDE = 1040, SK_BUF = 32 * SK_STRIDE;
template <class F> DI void skinny_task(LAS unsigned char* lds, const bf16* A, int lda, const bf16* Wt, int ldw, int n0, int k0, int klen, F epi) {
    const int tid = threadIdx.x, lane = tid & 63, l15 = lane & 15, kq = lane >> 4; const int wave = __builtin_amdgcn_readfirstlane(tid >> 6);
    typedef float f32x4v __attribute__((ext_vector_type(4)));
    const int wcol = tid >> 4, wpart = tid & 15;
    const bf16* wsrc = Wt + (size_t)(n0 + wcol) * ldw + k0 + wpart * 8;
    const bf16* asrc = A + (size_t)(16 * wave + l15) * lda + k0 + 8 * kq;
    const int nch = klen / SK_KC;
    u32x4 wreg[4];
#pragma unroll
    for (int i = 0; i < 4; ++i) wreg[i] = *(const u32x4*)(wsrc + i * 128);
#pragma unroll
    for (int i = 0; i < 4; ++i) *(LAS u32x4*)(lds + wcol * SK_STRIDE + (wpart + 16 * i) * 16) = wreg[i];
    __syncthreads();
    f32x4v acc0 = {0.f, 0.f, 0.f, 0.f}, acc1 = {0.f, 0.f, 0.f, 0.f};
#pragma unroll 1
    for (int c = 0; c < nch; ++c) {
        const bool more = (c + 1 < nch);
        if (more) {
#pragma unroll
            for (int i = 0; i < 4; ++i) wreg[i] = *(const u32x4*)(wsrc + (size_t)(c + 1) * SK_KC + i * 128); }
        bf16x8 af[16];
#pragma unroll
        for (int sI = 0; sI < 16; ++sI) af[sI] = *(const bf16x8*)(asrc + (size_t)c * SK_KC + 32 * sI);
        const LAS unsigned char* wb = lds + (c & 1) * SK_BUF;
#pragma unroll
        for (int sI = 0; sI < 16; ++sI) {
            const bf16x8 b0 = *(const LAS bf16x8*)(wb + l15 * SK_STRIDE + (32 * sI + 8 * kq) * 2);
            const bf16x8 b1 = *(const LAS bf16x8*)(wb + (16 + l15) * SK_STRIDE + (32 * sI + 8 * kq) * 2);
            acc0 = __builtin_amdgcn_mfma_f32_16x16x32_bf16(af[sI], b0, acc0, 0, 0, 0);
            acc1 = __builtin_amdgcn_mfma_f32_16x16x32_bf16(af[sI], b1, acc1, 0, 0, 0);
        }
        if (more) {
#pragma unroll
            for (int i = 0; i < 4; ++i) *(LAS u32x4*)(lds + ((c + 1) & 1) * SK_BUF + wcol * SK_STRIDE + (wpart + 16 * i) * 16) = wreg[i]; }
        __syncthreads();
    }
#pragma unroll
    for (int r = 0; r < 4; ++r) { const int row = 16 * wave + 4 * kq + r; epi(row, n0 + l15, acc0[r]); epi(row, n0 + 16 + l15, acc1[r]); }
}

constexpr int LRU_G = 0;
constexpr int LRU_XCB = 65536;
constexpr int LRU_COMP = 82944;
constexpr int LRU_CARRY = 87040;
constexpr int LRU_CARRY2 = 96256;
constexpr int LRU_LDS = 100352;
struct LruP { const bf16* proj; const bf16* wg; const float* conv_w; const float* conv_b; const float* bgx; const float* bga; const float* aparam;
              const float* state_conv; const float* state_h; float* agg; bf16* lruo; float* out_hs; };
template <int MODE>
DI void lru_unit(LAS unsigned char* lds, const LruP& P, int seqc  , int n, const LAS float* carry) {
    const int tid = threadIdx.x, lane = tid & 63; const int wave = __builtin_amdgcn_readfirstlane(tid >> 6);
    typedef float f32x2v __attribute__((ext_vector_type(2)));
    LAS float* G = (LAS float*)(lds + LRU_G); LAS float* XE = G; LAS f32x2v* COMP = (LAS f32x2v*)(lds + LRU_COMP);
    const int nrows = (MODE != 2 && seqc == 0) ? 16 : 64;
    const int row0 = (MODE == 2) ? ROW_SAMP + 64 * seqc : (seqc == 0 ? ROW_META : 64 * (seqc - 1));
    const int ch = tid & 127, cg = n * 128 + ch; const int seg = __builtin_amdgcn_readfirstlane(tid >> 7);
    const int r32 = lane & 31, hi = lane >> 5;
    bf16x8 bw[8];
    { const bf16* wp = P.wg + ((size_t)(n * 256 + 32 * wave + r32)) * 128 + 8 * hi;
#pragma unroll
      for (int ks = 0; ks < 8; ++ks) bw[ks] = *(const bf16x8*)(wp + 16 * ks); }
    float yv[16];
    if (MODE != 0) {
#pragma unroll
        for (int k = 0; k < 16; ++k) yv[k] = bf2f(P.proj[(size_t)(row0 + 16 * seg + k) * INW + C_YB + cg]); }
    if (MODE != 2) {
        for (int i = tid; i < 67 * 16; i += 512) { const int e = i >> 4, c8 = (i & 15) * 8; const int t = e - 3; u32x4 v = (u32x4){0u, 0u, 0u, 0u};
            if (t < nrows) { int row = -1;
                if (seqc == 0) { if (t >= 0) row = ROW_META + t; }
                else { const int tokn = 64 * (seqc - 1) + t; row = (tokn >= 0) ? tokn : ROW_META + 16 + tokn; }
                if (row >= 0) v = *(const u32x4*)(P.proj + (size_t)row * INW + C_XB + n * 128 + c8); }
            *(LAS f32x4*)(XE + e * 128 + c8) = (f32x4){bflo(v.x), bfhi(v.x), bflo(v.y), bfhi(v.y)};
            *(LAS f32x4*)(XE + e * 128 + c8 + 4) = (f32x4){bflo(v.z), bfhi(v.z), bflo(v.w), bfhi(v.w)}; }
        __syncthreads();
    }
    float xc[16];
    { const float w0 = P.conv_w[0 * LRUW + cg], w1 = P.conv_w[1 * LRUW + cg], w2 = P.conv_w[2 * LRUW + cg], w3 = P.conv_w[3 * LRUW + cg], cb = P.conv_b[cg];
      if (MODE != 2) {
          float x0 = XE[(16 * seg + 0) * 128 + ch], x1 = XE[(16 * seg + 1) * 128 + ch], x2 = XE[(16 * seg + 2) * 128 + ch];
#pragma unroll
          for (int k = 0; k < 16; ++k) { const float x3 = XE[(16 * seg + k + 3) * 128 + ch]; xc[k] = w0 * x0 + w1 * x1 + w2 * x2 + w3 * x3 + cb; x0 = x1; x1 = x2; x2 = x3; }
      } else {
#pragma unroll
          for (int k = 0; k < 16; ++k) { const int t = 16 * seg + k; const int b = 64 * seqc + t; const float* scp = P.state_conv + (size_t)b * 3 * LRUW + cg;
              xc[k] = w0 * scp[0] + w1 * scp[LRUW] + w2 * scp[2 * LRUW] + w3 * bf2f(P.proj[(size_t)(row0 + t) * INW + C_XB + cg]) + cb; }
      }
#pragma unroll
      for (int k = 0; k < 16; ++k) { const int t = 16 * seg + k; if (t >= nrows) xc[k] = 0.f;
          *(LAS bf16*)(lds + LRU_XCB + t * 272 + ch * 2) = (bf16)(pk2(xc[k], 0.f) & 0xffffu); } }
    __syncthreads();
    { f32x16 acc0 = {}, acc1 = {};
#pragma unroll
      for (int ks = 0; ks < 8; ++ks) {
          const bf16x8 a0 = *(const LAS bf16x8*)(lds + LRU_XCB + r32 * 272 + (16 * ks + 8 * hi) * 2);
          const bf16x8 a1 = *(const LAS bf16x8*)(lds + LRU_XCB + (r32 + 32) * 272 + (16 * ks + 8 * hi) * 2);
          acc0 = __builtin_amdgcn_mfma_f32_32x32x16_bf16(a0, bw[ks], acc0, 0, 0, 0);
          acc1 = __builtin_amdgcn_mfma_f32_32x32x16_bf16(a1, bw[ks], acc1, 0, 0, 0);
      }
      const int col = 32 * wave + r32;
      const float bias = (wave < 4) ? P.bgx[n * 128 + col] : P.bga[n * 128 + col - 128];
#pragma unroll
      for (int r = 0; r < 16; ++r) { const int t = crow(r, hi); G[t * 256 + col] = sigm(acc0[r] + bias); G[(t + 32) * 256 + col] = sigm(acc1[r] + bias); }
    }
    __syncthreads();
    float av[16], bv[16];
    { const float ap = P.aparam[cg]; const float ex = __expf(-ap);
      const float sp = (ex < 0.03f) ? ex * (1.0f - ex * (0.5f - ex * (0.333333333f - ex * (0.25f - ex * 0.2f)))) : logf(1.0f + ex);
#pragma unroll
      for (int k = 0; k < 16; ++k) { const int t = 16 * seg + k;
          const float gx = G[t * 256 + ch], ga = G[t * 256 + 128 + ch];
          const float loga = -8.0f * ga * sp; av[k] = __builtin_amdgcn_exp2f(LOG2E * loga); bv[k] = sqrtf(neg_expm1(2.0f * loga)) * gx * xc[k];
          if (MODE != 2 && t >= nrows) { av[k] = 1.f; bv[k] = 0.f; } } }
    if (MODE == 2) {
#pragma unroll
        for (int k = 0; k < 16; ++k) { const int t = 16 * seg + k; const int b = 64 * seqc + t;
            const float h = av[k] * P.state_h[(size_t)b * LRUW + cg] + bv[k]; P.out_hs[(size_t)b * LRUW + cg] = h;
            P.lruo[(size_t)(row0 + t) * 1024 + cg] = (bf16)(pk2(gelu_tanh(yv[k]) * h, 0.f) & 0xffffu); }
        __syncthreads();
        return;
    }
    { float p = 1.f, h = 0.f;
#pragma unroll
      for (int k = 0; k < 16; ++k) { h = av[k] * h + bv[k]; p *= av[k]; }
      COMP[seg * 128 + ch] = (f32x2v){p, h}; }
    __syncthreads();
    if (MODE == 0) {
        if (seg == 3) { float p = 1.f, h = 0.f;
#pragma unroll
            for (int sI = 0; sI < 4; ++sI) { const f32x2v c = COMP[sI * 128 + ch]; h = c.x * h + c.y; p *= c.x; }
            P.agg[((size_t)seqc * 2 + 0) * LRUW + cg] = p; P.agg[((size_t)seqc * 2 + 1) * LRUW + cg] = h; }
    } else {
        float h = carry[ch];
        for (int sI = 0; sI < seg; ++sI) { const f32x2v c = COMP[sI * 128 + ch]; h = c.x * h + c.y; }
#pragma unroll
        for (int k = 0; k < 16; ++k) { h = av[k] * h + bv[k];
            P.lruo[(size_t)(row0 + 16 * seg + k) * 1024 + cg] = (bf16)(pk2(gelu_tanh(yv[k]) * h, 0.f) & 0xffffu); }
    }
}

#define RLX_AGENT __ATOMIC_RELAXED, __HIP_MEMORY_SCOPE_AGENT
#define XB_TMO      128
#define XB_XCNT(j)  (256  + 64 * (j))
#define XB_XSUB(j)  (1280 + 64 * (j))
#define XB_XGEN(j)  (2304 + 64 * (j))
#define XB_TOP      3328
#define XB_TOPGEN   3392
#define XCD_BAR_WORDS 3456
#define XB_SPIN_CAP (1u << 18)
DI unsigned xb_ld(unsigned* p)              { return __hip_atomic_load(p, __ATOMIC_RELAXED, __HIP_MEMORY_SCOPE_AGENT); }
DI unsigned xb_add(unsigned* p, unsigned v) { return __hip_atomic_fetch_add(p, v, __ATOMIC_RELAXED, __HIP_MEMORY_SCOPE_AGENT); }
DI unsigned xb_xcc_id() { return (unsigned)__builtin_amdgcn_s_getreg((3 << 11) | 20) & 0xFu; }
#define XB_SPIN(cond, bar) do { unsigned _sp = 0; while (cond) { __builtin_amdgcn_s_sleep(1); \
    if ((++_sp & 255u) == 0u) { if (xb_ld(&(bar)[XB_TMO])) break; if (_sp > XB_SPIN_CAP) { atomicAdd(&(bar)[XB_TMO], 1u); break; } } } } while (0)
struct XcdBarrier { unsigned* bar; unsigned x; volatile LAS unsigned* st; };
DI XcdBarrier xcd_barrier_post(unsigned* bar, volatile LAS unsigned* st) {
    XcdBarrier b; b.bar = bar; b.x = xb_xcc_id(); b.st = st;
    if (threadIdx.x == 0) (void)xb_add(&bar[XB_XCNT(b.x)], 1u);
    return b;
}
DI void xcd_barrier_complete(unsigned* bar, unsigned x, unsigned& nloc, unsigned& nx) {
    const unsigned Gn = gridDim.x * gridDim.y * gridDim.z;
    unsigned sum, cnt, mine, sp = 0u;
    for (;;) {
        sum = 0u; cnt = 0u; mine = 0u;
#pragma unroll
        for (unsigned j = 0; j < 16; ++j) { const unsigned c = xb_ld(&bar[XB_XCNT(j)]); sum += c; cnt += (c > 0u) ? 1u : 0u; mine = (j == x) ? c : mine; }
        if (sum == Gn) break;
        __builtin_amdgcn_s_sleep(1);
        if ((++sp & 255u) == 0u) { if (xb_ld(&bar[XB_TMO])) break; if (sp > XB_SPIN_CAP) { atomicAdd(&bar[XB_TMO], 1u); break; } }
    }
    nloc = mine > 0u ? mine : 1u; nx = cnt > 0u ? cnt : 1u;
}
DI void xcd_barrier(const XcdBarrier& b) {
    asm volatile("s_waitcnt vmcnt(0)" ::: "memory");
    __syncthreads();
    if (threadIdx.x == 0) {
        unsigned* bar = b.bar;
        __builtin_amdgcn_s_waitcnt(0);
        unsigned nloc = b.st[0], nx = b.st[1];
        if (nloc == 0u) { xcd_barrier_complete(bar, b.x, nloc, nx); b.st[0] = nloc; b.st[1] = nx; }
        const unsigned old = xb_add(&bar[XB_XSUB(b.x)], 1u);
        const unsigned gen = old / nloc;
        if (old + 1u == (gen + 1u) * nloc) {
            __builtin_amdgcn_fence(__ATOMIC_RELEASE, "agent");
            asm volatile("s_waitcnt vmcnt(0)" ::: "memory");
            const unsigned og = xb_add(&bar[XB_TOP], 1u);
            const unsigned tg = og / nx;
            if (og + 1u == (tg + 1u) * nx) xb_add(&bar[XB_TOPGEN], 1u);
            else XB_SPIN(xb_ld(&bar[XB_TOPGEN]) == tg, bar);
            __builtin_amdgcn_fence(__ATOMIC_ACQUIRE, "agent");
            xb_add(&bar[XB_XGEN(b.x)], 1u);
            asm volatile("s_waitcnt vmcnt(0)" ::: "memory");
        } else {
            XB_SPIN(xb_ld(&bar[XB_XGEN(b.x)]) == gen, bar);
            __builtin_amdgcn_fence(__ATOMIC_ACQUIRE, "agent");
            asm volatile("s_waitcnt vmcnt(0)" ::: "memory");
        }
    }
    __syncthreads();
}
constexpr int MISC_OFF = 131072 + 320;
constexpr size_t WS_CTL = 0, CTL_ZERO_BYTES = 65536;
constexpr int CW_BAR = 4096;

typedef const Args __attribute__((address_space(4)))* KArgs;
#define KA() ({ KArgs p_ = (KArgs)__builtin_amdgcn_kernarg_segment_ptr(); asm volatile("" : "+s"(p_)); p_; })
__global__ void __launch_bounds__(NWAVES * 64, 2) griffin_fwd(Args args) {
    extern __shared__ __attribute__((aligned(16))) unsigned char lds_raw[];
    LAS unsigned char* lds = (LAS unsigned char*)lds_raw;
    const int tid = threadIdx.x, lane = tid & 63; const int wave = __builtin_amdgcn_readfirstlane(tid >> 6);
#define G ((int)gridDim.x)
#define bx ((int)blockIdx.x)
#define gw (bx * NWAVES + wave)
#define NGW (G * NWAVES)
#define ws (ka->ws)
#define out (ka->out)
#define x_prompt (ka->in[0])
#define x_sample (ka->in[1])
#define Wo_t ((bf16*)(ws + WS_WO))
#define Wup_t ((bf16*)(ws + WS_WUP))
#define Wdn_t ((bf16*)(ws + WS_WDN))
#define Wlru_t ((bf16*)(ws + WS_WLRU))
#define Watt_t ((bf16*)(ws + WS_WATT))
#define Wg_t ((bf16*)(ws + WS_WG))
#define Win_t ((bf16*)(ws + WS_WIN))
#define XN ((bf16*)(ws + WS_B))
#define PROJ ((bf16*)(ws + WS_PROJ))
#define VT ((bf16*)(ws + WS_VT))
#define LRUO ((bf16*)(ws + WS_LRUO))
#define ATTO ((bf16*)(ws + WS_ATTO))
#define MERGED ((bf16*)(ws + WS_C))
#define HB ((bf16*)(ws + WS_B))
#define UB ((bf16*)(ws + WS_U))
#define TAILF ((float*)(ws + WS_TAILF))
#define XTAIL ((float*)(ws + WS_XTAIL))
#define AGG ((float*)(ws + WS_AGG))
#define SS ((float*)(ws + WS_SS))
#define PART ((float*)(ws + WS_C))
    int lo, hi_ph; { const KArgs ka = KA(); lo = ka->ph_lo; hi_ph = ka->ph_hi; }
#if MK_N_LAUNCHES == 1 && !defined(ALL_CG_SYNC)
    if (tid < 32) ((LAS unsigned*)(lds + MISC_OFF))[tid] = 0u;
    __syncthreads();
    XcdBarrier xbar; { const KArgs ka = KA(); xbar = xcd_barrier_post((unsigned*)(ws + WS_CTL) + CW_BAR, (volatile LAS unsigned*)(lds + MISC_OFF) + 8); }
#endif
#ifndef DUP_PHASE
#define DUP_PHASE -1
#endif
#ifndef P2_PARTS
#define P2_PARTS 31
#endif
#ifndef PH_MASK
#define PH_MASK 0x1ff
#endif
#define IN(k) (((PH_MASK >> (k)) & 1) && lo <= (k) && (k) < hi_ph)
#if MK_N_LAUNCHES == 1
#if defined(ALL_CG_SYNC)
#define GRID_BAR(k) do { if (IN(k) && IN((k) + 1)) { cg::this_grid().sync(); } } while (0)
#else
#define GRID_BAR(k) do { if (IN(k) && IN((k) + 1)) { if ((k) == 0) cg::this_grid().sync(); else xcd_barrier(xbar); } } while (0)
#endif
#else
#define GRID_BAR(k) do { } while (0)
#endif

    if (IN(0)) {
        const KArgs ka = KA();
        LAS float* scr = (LAS float*)(lds + wave * 16384);
        constexpr int I_IN = 32 * 240, I_O = 32 * 64, I_UP = 32 * 256, I_DN = 128 * 64, I_L = 16 * 64, I_G = 128;
        constexpr int NITEMS = I_IN + I_O + I_UP + I_DN + 2 * I_L + I_G;
        for (int it = gw; it < NITEMS; it += NGW) {
            int r = it;
            if (r < I_IN) { p0_transpose_item(ka->in[10], DM, INW, Win_t, 0, nullptr, scr, r, lane); continue; } r -= I_IN;
            if (r < I_O) { p0_transpose_item(ka->in[21], DM, DM, Wo_t, 0, nullptr, scr, r, lane); continue; } r -= I_O;
            if (r < I_UP) { p0_transpose_item(ka->in[23], DM, DFF, Wup_t, 0, ka->in[22], scr, r, lane); continue; } r -= I_UP;
            if (r < I_DN) { p0_transpose_item(ka->in[24], DFF, DM, Wdn_t, 0, nullptr, scr, r, lane); continue; } r -= I_DN;
            if (r < I_L) { p0_transpose_item(ka->in[19], LRUW, DM, Wlru_t, 0, nullptr, scr, r, lane); continue; } r -= I_L;
            if (r < I_L) { p0_transpose_item(ka->in[20], LRUW, DM, Watt_t, 0, nullptr, scr, r, lane); continue; } r -= I_L;
            { const int nb = r >> 4, which = (r >> 3) & 1, sub = r & 7;
              p0_transpose_item((which ? ka->in[15] : ka->in[13]) + (size_t)nb * 128 * 128, 128, 128, Wg_t + (size_t)nb * 256 * 128, which * 128, nullptr, scr, sub, lane); }
        }
        for (int m = gw; m < MROWS; m += NGW) {
            const float* xr = (m < TX) ? x_prompt + (size_t)m * DM : (m < ROW_META) ? x_sample + (size_t)(m - ROW_SAMP) * DM : (m < ROW_PAD) ? ka->in[8] + (size_t)(m - ROW_META) * DM : nullptr;
            p0_norm_row(xr, ka->in[9], XN + (size_t)m * DM, (m >= TX) ? XTAIL + (size_t)(m - TX) * DM : nullptr, lane);
        }
        for (int i = bx * 512 + tid; i < MROWS; i += G * 512) SS[i] = 0.f;
    }
    GRID_BAR(0);

    if (IN(1)) {
        const KArgs ka = KA();
        pg8::Gemm g{XN, Win_t, MROWS, INW, DM};
        pg8::ProjOrder S; S.init(MROWS, INW, G, bx); S.n1 = MROWS / 256; S.vtile = C_V / 256;
        pg8::EpiProj E{PROJ, INW, VT, MROWS};
        pg8::gemm_phase<pg8::EpiProj, pg8::ProjOrder, true, true>(lds, g, S, E);
    }
    GRID_BAR(1);

    if (IN(2)) {
        const KArgs ka = KA();
        if (P2_PARTS & 1) for (int u = bx; u < 512; u += G) attn_unit(lds, PROJ, VT, ATTO, ka->in[18], u >> 2, u & 3);
        LruP LP{PROJ, Wg_t, ka->in[11], ka->in[12], ka->in[14], ka->in[16], ka->in[17], ka->in[6], ka->in[7], AGG, LRUO, out + O_HS};
        if (P2_PARTS & 2) for (int u = bx; u < NCHUNK_SEQ * 8; u += G) lru_unit<0>(lds, LP, u >> 3, u & 7, nullptr);
        if (P2_PARTS & 4) { const int u = bx - (G - 16); if (u >= 0) lru_unit<2>(lds, LP, u >> 3, u & 7, nullptr); }
        if (P2_PARTS & 8) for (int u = bx; u < 256; u += G) sample_attn_item(lds, PROJ, ka->in[2], ka->in[3], ka->in[4], ka->in[5], ka->in[18], ATTO, out + O_WKS, out + O_WVS, u >> 1, u & 1);
        const int gt = bx * 512 + tid, NT = G * 512;
        for (int i = gt; i < 16 * 256; i += NT) { const int r = i >> 8, c = i & 255; out[O_MK + i] = bf2f(PROJ[(size_t)(ROW_META + r) * INW + C_K + c]); out[O_MV + i] = bf2f(PROJ[(size_t)(ROW_META + r) * INW + C_V + c]); }
        for (int i = gt; i < 128 * 256; i += NT) { const int r = i >> 8, c = i & 255; out[O_WK + i] = bf2f(PROJ[(size_t)(TX - 128 + r) * INW + C_K + c]); out[O_WV + i] = bf2f(PROJ[(size_t)(TX - 128 + r) * INW + C_V + c]); }
        for (int i = gt; i < 3 * 1024; i += NT) { const int r = i >> 10, c = i & 1023; out[O_CONV + i] = bf2f(PROJ[(size_t)(TX - 3 + r) * INW + C_XB + c]); }
        for (int i = gt; i < 128 * 3 * 1024; i += NT) { const int b = i / 3072, r = (i / 1024) % 3, c = i & 1023;
            out[O_CONVS + i] = (r < 2) ? ka->in[6][((size_t)b * 3 + r + 1) * LRUW + c] : bf2f(PROJ[(size_t)(ROW_SAMP + b) * INW + C_XB + c]); }
        for (int i = gt; i < 128 * 128; i += NT) { const int row = ROW_META + (i >> 7), c8 = (i & 127) * 8;
            *(u32x4*)(ATTO + (size_t)row * 1024 + c8) = (u32x4){0u, 0u, 0u, 0u}; *(u32x4*)(LRUO + (size_t)row * 1024 + c8) = (u32x4){0u, 0u, 0u, 0u}; }
    }
    GRID_BAR(2);

    if (IN(3)) {
        const KArgs ka = KA();
        LruP LP{PROJ, Wg_t, ka->in[11], ka->in[12], ka->in[14], ka->in[16], ka->in[17], ka->in[6], ka->in[7], AGG, LRUO, out + O_HS};
        const int n = bx & 7, cb = bx >> 3, cstep = G >> 3;
        LAS float* carry = (LAS float*)(lds + LRU_CARRY2);
        {
            typedef float f32x2v __attribute__((ext_vector_type(2)));
            LAS f32x2v* RC = (LAS f32x2v*)(lds + LRU_CARRY);
            for (int task = tid; task < 9 * 128; task += 512) { const int rj = task >> 7, chn = task & 127;
                const int k0 = (rj == 0) ? 0 : cb + 1 + cstep * (rj - 1), k1 = (rj == 8) ? NCHUNK_SEQ : cb + 1 + cstep * rj;
                float p = 1.f, h = 0.f; const float* ap = AGG + (size_t)k0 * 2 * LRUW + n * 128 + chn;
                int k = k0;
                for (; k + 8 <= k1; k += 8) { float a8[8], b8[8];
#pragma unroll
                    for (int q = 0; q < 8; ++q) { a8[q] = ap[(size_t)(2 * q) * LRUW]; b8[q] = ap[(size_t)(2 * q + 1) * LRUW]; }
#pragma unroll
                    for (int q = 0; q < 8; ++q) { h = a8[q] * h + b8[q]; p *= a8[q]; }
                    ap += 16 * LRUW; }
                for (; k < k1; ++k) { const float a1 = ap[0], b1 = ap[LRUW]; h = a1 * h + b1; p *= a1; ap += 2 * LRUW; }
                RC[rj * 128 + chn] = (f32x2v){p, h}; }
            __syncthreads();
            if (tid < 128) { float h = 0.f;
#pragma unroll
                for (int rj = 0; rj < 9; ++rj) { const f32x2v c = RC[rj * 128 + tid]; h = c.x * h + c.y; if (rj < 8) carry[rj * 128 + tid] = h; }
                if (cb == 0) out[O_H + n * 128 + tid] = h; }
        }
        { int slot = 0; for (int c = cb; c < 256; c += cstep, ++slot) lru_unit<1>(lds, LP, c + 1, n, carry + slot * 128); }
        for (int t = bx; t < 64; t += G)
            skinny_task(lds, ATTO + (size_t)ROW_SAMP * 1024, 1024, Watt_t, 1024, 32 * t, 0, 1024, [&](int row, int col, float v) {
                TAILF[(size_t)row * DM + col] = sigm(bf2f(PROJ[(size_t)(ROW_SAMP + row) * INW + C_GA + col])) * v; });
        pg8::Gemm g{ATTO, Watt_t, TX, DM, 1024}; pg8::StaticOrder S; S.init(TX, DM, G, bx);
        pg8::EpiGateF32 E{pg8::BigBuf{out + O_Y, TAILF}, PROJ + C_GA, INW};
        pg8::gemm_phase<pg8::EpiGateF32, pg8::StaticOrder, true, true>(lds, g, S, E);
    }
    GRID_BAR(3);

    if (IN(4)) {
        const KArgs ka = KA();
        for (int t = bx; t < 64; t += G)
            skinny_task(lds, LRUO + (size_t)ROW_SAMP * 1024, 1024, Wlru_t, 1024, 32 * t, 0, 1024, [&](int row, int col, float v) {
                const float o = sigm(bf2f(PROJ[(size_t)(ROW_SAMP + row) * INW + C_GL + col])) * v + TAILF[(size_t)row * DM + col];
                MERGED[(size_t)(ROW_SAMP + row) * DM + col] = (bf16)(pk2(o, 0.f) & 0xffffu); });
        pg8::Gemm g{LRUO, Wlru_t, TX, DM, 1024}; pg8::StaticOrder S; S.init(TX, DM, G, bx);
        pg8::EpiMerge E{pg8::BigBufC{out + O_Y, TAILF}, PROJ + C_GL, INW, MERGED};
        pg8::gemm_phase<pg8::EpiMerge, pg8::StaticOrder, true, true>(lds, g, S, E);
    }
    GRID_BAR(4);

    if (IN(5)) {
        const KArgs ka = KA();
        for (int t = bx; t < 64; t += G)
            skinny_task(lds, MERGED + (size_t)ROW_SAMP * DM, DM, Wo_t, DM, 32 * t, 0, DM, [&](int row, int col, float v) {
                const float h = XTAIL[(size_t)row * DM + col] + v;
                TAILF[(size_t)row * DM + col] = h; HB[(size_t)(ROW_SAMP + row) * DM + col] = (bf16)(pk2(h, 0.f) & 0xffffu);
                float q = h * h; q += __shfl_xor(q, 1); q += __shfl_xor(q, 2); q += __shfl_xor(q, 4); q += __shfl_xor(q, 8);
                if ((threadIdx.x & 15) == 0) atomicAdd(SS + ROW_SAMP + row, q); });
        pg8::Gemm g{MERGED, Wo_t, TX, DM, DM}; pg8::StaticOrder S; S.init(TX, DM, G, bx);
        pg8::EpiResid E{pg8::BigBufC{x_prompt, XTAIL}, pg8::BigBuf{out + O_Y, TAILF}, HB, SS};
        pg8::gemm_phase<pg8::EpiResid, pg8::StaticOrder, true, true>(lds, g, S, E);
    }
    GRID_BAR(5);

    if (IN(6)) {
        const KArgs ka = KA();
        for (int t = bx; t < 256; t += G)
            skinny_task(lds, HB + (size_t)ROW_SAMP * DM, DM, Wup_t, DM, 32 * t, 0, DM, [&](int row, int col, float v) {
                const float a = fmaxf(v * __builtin_amdgcn_rsqf(SS[ROW_SAMP + row] * (1.0f / DM) + RMS_EPS), 0.f);
                UB[(size_t)(ROW_SAMP + row) * DFF + col] = (bf16)(pk2(a * a, 0.f) & 0xffffu); });
        pg8::Gemm g{HB, Wup_t, TX, DFF, DM}; pg8::StaticOrder S; S.init(TX, DFF, G, bx);
        pg8::EpiUp E{SS, UB};
        pg8::gemm_phase<pg8::EpiUp, pg8::StaticOrder, true, true>(lds, g, S, E);
    }
    GRID_BAR(6);

    if (IN(7)) {
        const KArgs ka = KA();
        for (int t = bx; t < 256; t += G) { const int ksp = t >> 6;
            skinny_task(lds, UB + (size_t)ROW_SAMP * DFF, DFF, Wdn_t, DFF, 32 * (t & 63), 2048 * ksp, 2048, [&](int row, int col, float v) {
                PART[((size_t)ksp * 128 + row) * DM + col] = v; }); }
        pg8::Gemm g{UB, Wdn_t, TX, DM, DFF}; pg8::StaticOrder S; S.init(TX, DM, G, bx);
#if DUP_PHASE == 7
        if (lo == 0) { pg8::EpiProj E0{HB, DM, HB, DM}; pg8::gemm_phase<pg8::EpiProj, pg8::StaticOrder, true, true>(lds, g, S, E0); } else
#endif
        { pg8::EpiDown E{pg8::BigBuf{out + O_Y, TAILF}};
        pg8::gemm_phase<pg8::EpiDown, pg8::StaticOrder, true, true>(lds, g, S, E); }
    }
    GRID_BAR(7);

    if (IN(8)) {
        const KArgs ka = KA();
        const float* gf = ka->in[25];
        for (int m = gw; m < TX + NSAMP; m += NGW) {
            const bool smp = (m >= TX);
            const float* src = smp ? TAILF + (size_t)(m - TX) * DM : out + O_Y + (size_t)m * DM;
            float* dst = smp ? out + O_YS + (size_t)(m - TX) * DM : out + O_Y + (size_t)m * DM;
            f32x4 v[8]; float s = 0.f;
#pragma unroll
            for (int j = 0; j < 8; ++j) { v[j] = *((const f32x4*)src + lane + 64 * j);
                if (smp) {
#pragma unroll
                    for (int ks = 0; ks < 4; ++ks) v[j] += *((const f32x4*)(PART + ((size_t)ks * 128 + (m - TX)) * DM) + lane + 64 * j); }
                s += (v[j].x * v[j].x + v[j].y * v[j].y) + (v[j].z * v[j].z + v[j].w * v[j].w); }
            const float r = __builtin_amdgcn_rsqf(wave_sum(s) * (1.0f / DM) + RMS_EPS);
#pragma unroll
            for (int j = 0; j < 8; ++j) { const f32x4 gg = *((const f32x4*)gf + lane + 64 * j); *((f32x4*)dst + lane + 64 * j) = v[j] * r * gg; }
        }
    }
#undef IN
#undef GRID_BAR
#undef G
#undef bx
#undef gw
#undef NGW
#undef ws
#undef out
#undef x_prompt
#undef x_sample
}

extern "C" void kernel_launch(void* const* d_in, const int* in_sizes, int n_in, void* d_out, int out_size, void* d_ws, size_t ws_size, hipStream_t stream) {
    static int grid = 0;
    if (grid == 0) {
        if (n_in != 26 || (size_t)out_size != O_END || ws_size < WS_END) { fprintf(stderr, "kernel_launch: unexpected shapes (n_in %d, out %d, ws %zu)\n", n_in, out_size, ws_size); grid = -1; return; }
        int dev = 0, cus = 0, per_cu = 0;
        if (hipGetDevice(&dev) != hipSuccess || hipDeviceGetAttribute(&cus, hipDeviceAttributeMultiprocessorCount, dev) != hipSuccess) { grid = -1; return; }
        if (hipFuncSetAttribute((const void*)griffin_fwd, hipFuncAttributeMaxDynamicSharedMemorySize, LDS_BYTES) != hipSuccess) { fprintf(stderr, "kernel_launch: hipFuncSetAttribute failed\n"); grid = -1; return; }
        if (hipOccupancyMaxActiveBlocksPerMultiprocessor(&per_cu, (const void*)griffin_fwd, NWAVES * 64, LDS_BYTES) != hipSuccess || per_cu < 1) { fprintf(stderr, "kernel_launch: occupancy query says %d\n", per_cu); (void)hipGetLastError(); grid = -1; return; }
        grid = cus;
        if (grid % 8 != 0 || grid > 256) { fprintf(stderr, "kernel_launch: unexpected CU count %d\n", cus); if (grid > 256) grid = 256; }
    }
    if (grid < 0) return;
    Args a{};
    for (int i = 0; i < 26; ++i) a.in[i] = (const float*)d_in[i];
    a.out = (float*)d_out; a.ws = (unsigned char*)d_ws;
    if (MK_N_LAUNCHES == 1) {
        const int ncut = (DUP_PHASE >= 0) ? 2 : 1;
        const int kd = DUP_PHASE % 100;
        for (int li = 0; li < ncut; ++li) {
            if (ncut == 1) { a.ph_lo = 0; a.ph_hi = N_PHASES; }
            else if (li == 0) { a.ph_lo = 0; a.ph_hi = kd + 1; }
            else { a.ph_lo = (DUP_PHASE >= 100) ? kd + 1 : kd; a.ph_hi = N_PHASES; }
            if (hipMemsetAsync((char*)d_ws + WS_CTL, 0, CTL_ZERO_BYTES, stream) != hipSuccess) { fprintf(stderr, "kernel_launch: hipMemsetAsync failed\n"); return; }
            if (li == 1 && DUP_PHASE == 5) (void)hipMemsetAsync((char*)d_ws + WS_SS, 0, (size_t)MROWS * 4, stream);
            void* kargs[] = {&a};
            hipError_t e = hipLaunchCooperativeKernel((const void*)griffin_fwd, dim3(grid), dim3(NWAVES * 64), kargs, LDS_BYTES, stream);
            if (e != hipSuccess) fprintf(stderr, "kernel_launch: cooperative launch failed: %s (grid %d)\n", hipGetErrorString(e), grid);
        }
    } else {
        for (int p = 0; p < N_PHASES; ++p) { a.ph_lo = p; a.ph_hi = p + 1; hipLaunchKernelGGL(griffin_fwd, dim3(grid), dim3(NWAVES * 64), LDS_BYTES, stream, a); }
    }
}
```

```cpp
#include <hip/hip_runtime.h>
#include <hip/hip_cooperative_groups.h>
#include <cstdio>
#include <cstdint>
namespace cg = cooperative_groups;

#ifndef MK_N_LAUNCHES
#define MK_N_LAUNCHES 1
#endif
constexpr int N_PHASES = 9;

namespace pg8 {
#define PG8_LAS __attribute__((address_space(3)))
typedef unsigned short bf16_t;
typedef short bf16x8 __attribute__((ext_vector_type(8)));
typedef float f32x4 __attribute__((ext_vector_type(4)));
typedef unsigned u32x4 __attribute__((ext_vector_type(4)));
constexpr int BM = 256, BK = 64, HALF = 128, HTB = HALF * BK * 2, STAGE_BYTES = 8 * HTB, NXCD = 8, WGM = 8;

__host__ __device__ __forceinline__ int lds_byte(int r, int c) { const int st = (r >> 4) * 2 + (c >> 5), rr = r & 15, cc = c & 31, ob = rr * 64 + cc * 2; return st * 1024 + (ob ^ (((ob >> 9) & 1) << 5)); }
__host__ __device__ __forceinline__ void stage_rc(int b, int& R, int& C) { const int st = b / 1024, sb = b % 1024, swz = sb ^ (((sb >> 9) & 1) << 5); R = (st >> 1) * 16 + swz / 64; C = (st & 1) * 32 + (swz % 64) / 2; }
__host__ __device__ __forceinline__ int perm32(int rho) { const int n = rho >> 4, i = rho & 15; return 8 * (i >> 2) + 4 * n + (i & 3); }

struct Unit { int pm, pn, kind; };
struct Gemm { const bf16_t* A; const bf16_t* Bt; int M, N, K; };

struct StaticOrder {
    int nM, nN, nwg, G, c;
    __host__ __device__ void init(int M, int N, int G_, int c_) { nM = M / BM; nN = N / BM; nwg = nM * nN; G = G_; c = c_; }
    __host__ __device__ bool next(int i, Unit& u) const {
        const long L = (long)i * G + c; if (L >= nwg) return false;
        int wgid = (int)L; { const int q = nwg / NXCD, r = nwg % NXCD, xcd = wgid % NXCD, off = wgid / NXCD; wgid = (xcd < r ? xcd * (q + 1) : r * (q + 1) + (xcd - r) * q) + off; }
        const int nig = WGM * nN, gid = wgid / nig, fm = gid * WGM, gsz = (nM - fm) < WGM ? (nM - fm) : WGM;
        u.pm = fm + ((wgid % nig) % gsz); u.pn = (wgid % nig) / gsz; u.kind = 0; return true;
    }
    __device__ __forceinline__ const char* a_tile(const Gemm& g, const Unit& u, size_t tstep) const { return (const char*)g.A + (size_t)u.pm * tstep; }
    __device__ __forceinline__ const char* b_tile(const Gemm& g, const Unit& u, size_t tstep) const { return (const char*)g.Bt + (size_t)u.pn * tstep; }
    __device__ __forceinline__ void a_ready(const Unit&) const {}
    __device__ __forceinline__ void done(const Unit&) const {}
};
struct ProjOrder : StaticOrder {
    int n1, vtile;
    __host__ __device__ bool next(int i, Unit& u) const {
        const long L = (long)i * G + c; if (L < nwg) return StaticOrder::next(i, u);
        if (L >= nwg + n1) return false;
        u.pm = 0; u.pn = (int)(L - nwg); u.kind = 1; return true;
    }
    __device__ __forceinline__ const char* a_tile(const Gemm& g, const Unit& u, size_t tstep) const { return u.kind ? (const char*)g.Bt + (size_t)vtile * tstep : (const char*)g.A + (size_t)u.pm * tstep; }
    __device__ __forceinline__ const char* b_tile(const Gemm& g, const Unit& u, size_t tstep) const { return u.kind ? (const char*)g.A + (size_t)u.pn * tstep : (const char*)g.Bt + (size_t)u.pn * tstep; }
};

typedef float f32x2_t __attribute__((ext_vector_type(2))); typedef __bf16 bf16x2_t __attribute__((ext_vector_type(2)));
__device__ __forceinline__ unsigned cvt_pk_bf16(float lo, float hi) { f32x2_t v = {lo, hi}; bf16x2_t b = __builtin_convertvector(v, bf16x2_t); return __builtin_bit_cast(unsigned, b); }
__device__ __forceinline__ float bf_lo(unsigned w) { return __uint_as_float(w << 16); }
__device__ __forceinline__ float bf_hi(unsigned w) { return __uint_as_float(w & 0xffff0000u); }
__device__ __forceinline__ float sigmoidf_(float x) { return __builtin_amdgcn_rcpf(1.0f + __builtin_amdgcn_exp2f(-1.4426950408889634f * x)); }

struct EpiProj {
    static constexpr bool PERM = true, HAS_MID = false;
    bf16_t* O0; int ldc0; bf16_t* O1; int ldc1;
    __device__ __forceinline__ void operator()(const f32x4 (&acc)[2][2][4][2], const Unit& u, int wr, int wc, int fr, int fq) const {
        bf16_t* O = u.kind ? O1 : O0; const int ldc = u.kind ? ldc1 : ldc0;
        const int row0 = u.pm * BM + wr * 64 + fr; const int col0 = u.pn * BM + wc * 32 + 8 * fq;
#pragma unroll
        for (int ai = 0; ai < 2; ++ai)
#pragma unroll
            for (int m = 0; m < 4; ++m) { bf16_t* rowp = O + (size_t)(row0 + ai * HALF + m * 16) * ldc + col0;
#pragma unroll
                for (int bj = 0; bj < 2; ++bj) { const f32x4 v0 = acc[ai][bj][m][0], v1 = acc[ai][bj][m][1];
                    u32x4 w; w.x = cvt_pk_bf16(v0[0], v0[1]); w.y = cvt_pk_bf16(v0[2], v0[3]); w.z = cvt_pk_bf16(v1[0], v1[1]); w.w = cvt_pk_bf16(v1[2], v1[3]);
                    *(u32x4*)(rowp + bj * HALF) = w; } }
    }
};
struct EpiNull {
    static constexpr bool PERM = true, HAS_MID = false;
    __device__ __forceinline__ void operator()(const f32x4 (&acc)[2][2][4][2], const Unit& u, int wr, int wc, int fr, int fq) const {
#pragma unroll
        for (int ai = 0; ai < 2; ++ai)
#pragma unroll
            for (int bj = 0; bj < 2; ++bj)
#pragma unroll
                for (int m = 0; m < 4; ++m)
#pragma unroll
                    for (int n = 0; n < 2; ++n) asm volatile("" :: "v"(acc[ai][bj][m][n]));
    }
};
struct EpiMergeFused {
    static constexpr bool PERM = true, HAS_MID = true;
    const bf16_t* ga; const bf16_t* gl; int gld; bf16_t* O;
    __device__ __forceinline__ void mid(f32x4 (&acc)[2][2][4][2], const Unit& u, int wr, int wc, int fr, int fq) const {
        int rl0 = wr * 64 + fr; int col0 = u.pn * BM + wc * 32 + 8 * fq;
        asm volatile("" : "+v"(rl0), "+v"(col0));
#pragma unroll
        for (int ai = 0; ai < 2; ++ai)
#pragma unroll
            for (int m = 0; m < 4; ++m) { const size_t grow = (size_t)(u.pm * BM + rl0 + ai * HALF + m * 16);
                const bf16_t* ap = ga + grow * gld + col0; const bf16_t* lp = gl + grow * gld + col0;
#pragma unroll
                for (int bj = 0; bj < 2; ++bj) { const u32x4 a = *(const u32x4*)(ap + bj * HALF), l = *(const u32x4*)(lp + bj * HALF);
#define MF_RATIO(aw, lw, HI) ((1.0f + __builtin_amdgcn_exp2f(-1.4426950408889634f * (HI ? bf_hi(lw) : bf_lo(lw)))) * __builtin_amdgcn_rcpf(1.0f + __builtin_amdgcn_exp2f(-1.4426950408889634f * (HI ? bf_hi(aw) : bf_lo(aw)))))
                    f32x4& v0 = acc[ai][bj][m][0]; f32x4& v1 = acc[ai][bj][m][1];
                    v0[0] *= MF_RATIO(a.x, l.x, 0); v0[1] *= MF_RATIO(a.x, l.x, 1); v0[2] *= MF_RATIO(a.y, l.y, 0); v0[3] *= MF_RATIO(a.y, l.y, 1);
                    v1[0] *= MF_RATIO(a.z, l.z, 0); v1[1] *= MF_RATIO(a.z, l.z, 1); v1[2] *= MF_RATIO(a.w, l.w, 0); v1[3] *= MF_RATIO(a.w, l.w, 1);
#undef MF_RATIO
                }
                asm volatile("" ::: "memory"); }
    }
    __device__ __forceinline__ void operator()(const f32x4 (&acc)[2][2][4][2], const Unit& u, int wr, int wc, int fr, int fq) const {
        const int rl0 = wr * 64 + fr; const int col0 = u.pn * BM + wc * 32 + 8 * fq;
#pragma unroll
        for (int ai = 0; ai < 2; ++ai)
#pragma unroll
            for (int m = 0; m < 4; ++m) { const size_t grow = (size_t)(u.pm * BM + rl0 + ai * HALF + m * 16);
                const bf16_t* lp = gl + grow * gld + col0; bf16_t* op = O + grow * 2048 + col0;
#pragma unroll
                for (int bj = 0; bj < 2; ++bj) { const u32x4 g = *(const u32x4*)(lp + bj * HALF); const f32x4 v0 = acc[ai][bj][m][0], v1 = acc[ai][bj][m][1];
                    f32x4 o0, o1;
                    o0[0] = sigmoidf_(bf_lo(g.x)) * v0[0]; o0[1] = sigmoidf_(bf_hi(g.x)) * v0[1]; o0[2] = sigmoidf_(bf_lo(g.y)) * v0[2]; o0[3] = sigmoidf_(bf_hi(g.y)) * v0[3];
                    o1[0] = sigmoidf_(bf_lo(g.z)) * v1[0]; o1[1] = sigmoidf_(bf_hi(g.z)) * v1[1]; o1[2] = sigmoidf_(bf_lo(g.w)) * v1[2]; o1[3] = sigmoidf_(bf_hi(g.w)) * v1[3];
                    u32x4 w; w.x = cvt_pk_bf16(o0[0], o0[1]); w.y = cvt_pk_bf16(o0[2], o0[3]); w.z = cvt_pk_bf16(o1[0], o1[1]); w.w = cvt_pk_bf16(o1[2], o1[3]);
                    *(u32x4*)(op + bj * HALF) = w; }
                asm volatile("" ::: "memory"); }
    }
};
struct EpiResid {
    static constexpr bool PERM = true, HAS_MID = false;
    const float* X; bf16_t* HB; float* ss;
    __device__ __forceinline__ void operator()(const f32x4 (&acc)[2][2][4][2], const Unit& u, int wr, int wc, int fr, int fq) const {
        const int rl0 = wr * 64 + fr; const int col0 = u.pn * BM + wc * 32 + 8 * fq;
#pragma unroll
        for (int ai = 0; ai < 2; ++ai)
#pragma unroll
            for (int m = 0; m < 4; ++m) { const size_t grow = (size_t)(u.pm * BM + rl0 + ai * HALF + m * 16);
                const float* xp = X + grow * 2048 + col0; bf16_t* op = HB + grow * 2048 + col0; float q = 0.f;
#pragma unroll
                for (int bj = 0; bj < 2; ++bj) { const f32x4 x0 = *(const f32x4*)(xp + bj * HALF), x1 = *(const f32x4*)(xp + bj * HALF + 4);
                    const f32x4 o0 = acc[ai][bj][m][0] + x0, o1 = acc[ai][bj][m][1] + x1;
                    q += (o0[0] * o0[0] + o0[1] * o0[1]) + (o0[2] * o0[2] + o0[3] * o0[3]) + (o1[0] * o1[0] + o1[1] * o1[1]) + (o1[2] * o1[2] + o1[3] * o1[3]);
                    u32x4 w; w.x = cvt_pk_bf16(o0[0], o0[1]); w.y = cvt_pk_bf16(o0[2], o0[3]); w.z = cvt_pk_bf16(o1[0], o1[1]); w.w = cvt_pk_bf16(o1[2], o1[3]);
                    *(u32x4*)(op + bj * HALF) = w; }
                q += __shfl_xor(q, 16); q += __shfl_xor(q, 32);
                if (fq == 0) atomicAdd(ss + grow, q);
                asm volatile("" ::: "memory"); }
    }
};
struct EpiUp {
    static constexpr bool PERM = true, HAS_MID = false;
    const float* ss; bf16_t* O;
    __device__ __forceinline__ void operator()(const f32x4 (&acc)[2][2][4][2], const Unit& u, int wr, int wc, int fr, int fq) const {
        const int row0 = u.pm * BM + wr * 64 + fr; const int col0 = u.pn * BM + wc * 32 + 8 * fq;
        float rs[2][4];
#pragma unroll
        for (int ai = 0; ai < 2; ++ai)
#pragma unroll
            for (int m = 0; m < 4; ++m) rs[ai][m] = __builtin_amdgcn_rsqf(ss[row0 + ai * HALF + m * 16] * (1.0f / 2048.0f) + 1e-6f);
#pragma unroll
        for (int ai = 0; ai < 2; ++ai)
#pragma unroll
            for (int m = 0; m < 4; ++m) { bf16_t* rowp = O + (size_t)(row0 + ai * HALF + m * 16) * 8192 + col0; const float r = rs[ai][m];
#pragma unroll
                for (int bj = 0; bj < 2; ++bj) { f32x4 v0 = acc[ai][bj][m][0] * r, v1 = acc[ai][bj][m][1] * r;
#pragma unroll
                    for (int j = 0; j < 4; ++j) { const float a = fmaxf(v0[j], 0.f), b = fmaxf(v1[j], 0.f); v0[j] = a * a; v1[j] = b * b; }
                    u32x4 w; w.x = cvt_pk_bf16(v0[0], v0[1]); w.y = cvt_pk_bf16(v0[2], v0[3]); w.z = cvt_pk_bf16(v1[0], v1[1]); w.w = cvt_pk_bf16(v1[2], v1[3]);
                    *(u32x4*)(rowp + bj * HALF) = w; } }
    }
};
struct EpiDown {
    static constexpr bool PERM = true, HAS_MID = false;
    const bf16_t* HB; float* Y;
    __device__ __forceinline__ void operator()(const f32x4 (&acc)[2][2][4][2], const Unit& u, int wr, int wc, int fr, int fq) const {
        const int rl0 = wr * 64 + fr; const int col0 = u.pn * BM + wc * 32 + 8 * fq;
#pragma unroll
        for (int ai = 0; ai < 2; ++ai)
#pragma unroll
            for (int m = 0; m < 4; ++m) { const size_t grow = (size_t)(u.pm * BM + rl0 + ai * HALF + m * 16); const bf16_t* hp = HB + grow * 2048 + col0; float* yp = Y + grow * 2048 + col0;
#pragma unroll
                for (int bj = 0; bj < 2; ++bj) { const u32x4 h = *(const u32x4*)(hp + bj * HALF);
                    const f32x4 x0 = (f32x4){bf_lo(h.x), bf_hi(h.x), bf_lo(h.y), bf_hi(h.y)}, x1 = (f32x4){bf_lo(h.z), bf_hi(h.z), bf_lo(h.w), bf_hi(h.w)};
                    *(f32x4*)(yp + bj * HALF) = acc[ai][bj][m][0] + x0; *(f32x4*)(yp + bj * HALF + 4) = acc[ai][bj][m][1] + x1; }
                asm volatile("" ::: "memory"); }
    }
};

template <class Epi, class Sched, bool ALIGN_EPI = false, bool SP2 = false>
__device__ __forceinline__ void gemm_phase(PG8_LAS unsigned char* lds, const Gemm g, const Sched& S, const Epi& E) {
    const int tid = threadIdx.x, wid = __builtin_amdgcn_readfirstlane(tid >> 6), lane = tid & 63, wr = wid >> 2, wc = wid & 3, fr = lane & 15, fq = lane >> 4;
    const int K = g.K, nt = K / BK;
    unsigned voffA[2], voffB[2];
#pragma unroll
    for (int i = 0; i < 2; ++i) { int R, C; stage_rc(tid * 16 + i * 8192, R, C); const int Rb = Epi::PERM ? ((R & ~31) + perm32(R & 31)) : R;
        voffA[i] = (unsigned)(R * K + C) * 2u; voffB[i] = (unsigned)(Rb * K + C) * 2u; }
    const size_t kstep = (size_t)(BK * 2);
    const size_t hstep = (size_t)HALF * K * 2;
    const size_t tstep = 2 * hstep;
    const unsigned ldsw = (unsigned)wid * 1024u;
    const int aoff = lds_byte(wr * 64 + fr, fq * 8), boff = lds_byte(wc * 32 + fr, fq * 8);
#define PG8_SA(b, h) (((b) * 2 + (h)) * HTB)
#define PG8_SB(b, h) ((4 + (b) * 2 + (h)) * HTB)
#define PG8_STAGE(bufoff, gbase, voff) do { _Pragma("unroll") for (int _i = 0; _i < 2; ++_i) \
        __builtin_amdgcn_global_load_lds((const unsigned*)((const char*)(gbase) + (voff)[_i]), (PG8_LAS unsigned*)(lds + (bufoff) + ldsw + _i * 8192), 16, 0, 0); } while (0)
#define PG8_LDA(dst, b, h) do { _Pragma("unroll") for (int m = 0; m < 4; ++m) _Pragma("unroll") for (int k = 0; k < 2; ++k) dst[m][k] = *(const PG8_LAS bf16x8*)(lds + PG8_SA(b, h) + aoff + m * 2048 + k * 1024); } while (0)
#define PG8_LDB(dst, b, h) do { _Pragma("unroll") for (int n = 0; n < 2; ++n) _Pragma("unroll") for (int k = 0; k < 2; ++k) dst[n][k] = *(const PG8_LAS bf16x8*)(lds + PG8_SB(b, h) + boff + n * 2048 + k * 1024); } while (0)
#define PG8_MMA(ai, bj, At, Bt) do { __builtin_amdgcn_s_setprio(1); _Pragma("unroll") for (int m = 0; m < 4; ++m) _Pragma("unroll") for (int n = 0; n < 2; ++n) _Pragma("unroll") for (int k = 0; k < 2; ++k) \
        acc[ai][bj][m][n] = __builtin_amdgcn_mfma_f32_16x16x32_bf16(Bt[n][k], At[m][k], acc[ai][bj][m][n], 0, 0, 0); __builtin_amdgcn_s_setprio(0); } while (0)
#define PG8_WAIT_V(n) asm volatile("s_waitcnt vmcnt(" #n ")" ::: "memory")
#define PG8_WAIT_L(n) asm volatile("s_waitcnt lgkmcnt(" #n ")" ::: "memory")
#define PG8_BAR __builtin_amdgcn_s_barrier()
#define PG8_SCHED __builtin_amdgcn_sched_barrier(0)
    Unit cur, nxt; int ui = 0;
    if (!S.next(0, cur)) return;
    f32x4 acc[2][2][4][2];
#pragma unroll
    for (int a = 0; a < 2; ++a)
#pragma unroll
        for (int b = 0; b < 2; ++b)
#pragma unroll
            for (int m = 0; m < 4; ++m)
#pragma unroll
                for (int n = 0; n < 2; ++n) acc[a][b][m][n] = (f32x4){0.f, 0.f, 0.f, 0.f};
    bf16x8 At[4][2], B0[2][2], B1[2][2];
    const char* cA = S.a_tile(g, cur, tstep); const char* cB = S.b_tile(g, cur, tstep);
    S.a_ready(cur);
    if constexpr (SP2) {
        PG8_STAGE(PG8_SB(0, 0), cB, voffB); PG8_STAGE(PG8_SB(0, 1), cB + hstep, voffB); PG8_STAGE(PG8_SA(0, 0), cA, voffA); PG8_STAGE(PG8_SA(0, 1), cA + hstep, voffA);
        if (wr == 1) PG8_BAR;
        PG8_WAIT_V(2); PG8_BAR;
        PG8_STAGE(PG8_SB(1, 0), cB + kstep, voffB); PG8_STAGE(PG8_SA(1, 0), cA + kstep, voffA); PG8_STAGE(PG8_SB(1, 1), cB + hstep + kstep, voffB);
        PG8_WAIT_V(6); PG8_BAR;
    } else {
        PG8_STAGE(PG8_SB(0, 0), cB, voffB); PG8_STAGE(PG8_SA(0, 0), cA, voffA); PG8_STAGE(PG8_SB(0, 1), cB + hstep, voffB); PG8_STAGE(PG8_SA(0, 1), cA + hstep, voffA);
        if (wr == 1) PG8_BAR;
        PG8_WAIT_V(4); PG8_BAR;
        PG8_STAGE(PG8_SB(1, 0), cB + kstep, voffB); PG8_STAGE(PG8_SA(1, 0), cA + kstep, voffA); PG8_STAGE(PG8_SB(1, 1), cB + hstep + kstep, voffB);
        PG8_WAIT_V(6); PG8_BAR;
    }
    for (;;) {
        const bool has_next = S.next(ui + 1, nxt);
        const char* nA = has_next ? S.a_tile(g, nxt, tstep) : cA; const char* nB = has_next ? S.b_tile(g, nxt, tstep) : cB;
        for (int t = 0; t < nt; t += 2) {
            const bool last = (t == nt - 2);
            const char* a1 = cA + (size_t)(t + 1) * kstep;
            const char* a2 = last ? nA : cA + (size_t)(t + 2) * kstep; const char* b2 = last ? nB : cB + (size_t)(t + 2) * kstep;
            const char* a3 = a2 + kstep; const char* b3 = b2 + kstep;
            if (last && has_next) S.a_ready(nxt);
            if constexpr (Epi::HAS_MID) { if (t == nt / 2) E.mid(acc, cur, wr, wc, fr, fq); }
            if constexpr (SP2) {
            PG8_LDB(B0, 0, 0); PG8_LDB(B1, 0, 1); PG8_SCHED; PG8_LDA(At, 0, 0); PG8_STAGE(PG8_SA(1, 1), a1 + hstep, voffA);
            PG8_WAIT_V(8); PG8_WAIT_L(0); PG8_BAR; PG8_MMA(0, 0, At, B0); PG8_MMA(0, 1, At, B1); PG8_BAR; PG8_SCHED;
            PG8_LDA(At, 0, 1); PG8_STAGE(PG8_SB(0, 0), b2, voffB); PG8_STAGE(PG8_SB(0, 1), b2 + hstep, voffB); PG8_STAGE(PG8_SA(0, 0), a2, voffA);
            PG8_WAIT_V(8); PG8_WAIT_L(0); PG8_BAR; PG8_MMA(1, 0, At, B0); PG8_MMA(1, 1, At, B1); PG8_BAR; PG8_SCHED;
            PG8_LDB(B0, 1, 0); PG8_LDB(B1, 1, 1); PG8_SCHED; PG8_LDA(At, 1, 0); PG8_STAGE(PG8_SA(0, 1), a2 + hstep, voffA);
            PG8_WAIT_V(8); PG8_WAIT_L(0); PG8_BAR; PG8_MMA(0, 0, At, B0); PG8_MMA(0, 1, At, B1); PG8_BAR; PG8_SCHED;
            PG8_LDA(At, 1, 1); PG8_STAGE(PG8_SB(1, 0), b3, voffB); PG8_STAGE(PG8_SB(1, 1), b3 + hstep, voffB); PG8_STAGE(PG8_SA(1, 0), a3, voffA);
            PG8_WAIT_V(8); PG8_WAIT_L(0); PG8_BAR; PG8_MMA(1, 0, At, B0); PG8_MMA(1, 1, At, B1); PG8_BAR; PG8_SCHED;
            } else {
            PG8_LDB(B0, 0, 0); PG8_SCHED; PG8_LDA(At, 0, 0); PG8_STAGE(PG8_SA(1, 1), a1 + hstep, voffA);
            PG8_WAIT_L(8); PG8_BAR; PG8_WAIT_L(0); PG8_MMA(0, 0, At, B0); PG8_BAR; PG8_SCHED;
            PG8_LDB(B1, 0, 1); PG8_STAGE(PG8_SB(0, 0), b2, voffB);
            PG8_BAR; PG8_WAIT_L(0); PG8_MMA(0, 1, At, B1); PG8_BAR;
            PG8_LDA(At, 0, 1); PG8_STAGE(PG8_SA(0, 0), a2, voffA);
            PG8_BAR; PG8_WAIT_L(0); PG8_MMA(1, 0, At, B0); PG8_BAR; PG8_SCHED;
            PG8_STAGE(PG8_SB(0, 1), b2 + hstep, voffB);
            PG8_WAIT_V(6); PG8_BAR; PG8_MMA(1, 1, At, B1); PG8_BAR;
            PG8_LDB(B0, 1, 0); PG8_SCHED; PG8_LDA(At, 1, 0); PG8_STAGE(PG8_SA(0, 1), a2 + hstep, voffA);
            PG8_WAIT_L(8); PG8_BAR; PG8_WAIT_L(0); PG8_MMA(0, 0, At, B0); PG8_BAR; PG8_SCHED;
            PG8_LDB(B1, 1, 1); PG8_STAGE(PG8_SB(1, 0), b3, voffB);
            PG8_BAR; PG8_WAIT_L(0); PG8_MMA(0, 1, At, B1); PG8_BAR;
            PG8_LDA(At, 1, 1); PG8_STAGE(PG8_SA(1, 0), a3, voffA);
            PG8_BAR; PG8_WAIT_L(0); PG8_MMA(1, 0, At, B0); PG8_BAR; PG8_SCHED;
            PG8_STAGE(PG8_SB(1, 1), b3 + hstep, voffB);
            PG8_WAIT_V(6); PG8_BAR; PG8_MMA(1, 1, At, B1); PG8_BAR;
            }
        }
        if constexpr (ALIGN_EPI) { if (wr == 0) PG8_BAR; }
        E(acc, cur, wr, wc, fr, fq); S.done(cur);
        if (!has_next) break;
#pragma unroll
        for (int a = 0; a < 2; ++a)
#pragma unroll
            for (int b = 0; b < 2; ++b)
#pragma unroll
                for (int m = 0; m < 4; ++m)
#pragma unroll
                    for (int n = 0; n < 2; ++n) acc[a][b][m][n] = (f32x4){0.f, 0.f, 0.f, 0.f};
        cur = nxt; cA = nA; cB = nB; ++ui;
        if constexpr (ALIGN_EPI) { if (wr == 1) PG8_BAR; }
    }
    PG8_WAIT_V(0);
    if constexpr (!ALIGN_EPI) { if (wr == 0) PG8_BAR; }
    PG8_BAR;
#undef PG8_SA
#undef PG8_SB
#undef PG8_STAGE
#undef PG8_LDA
#undef PG8_LDB
#undef PG8_MMA
#undef PG8_WAIT_V
#undef PG8_WAIT_L
#undef PG8_BAR
#undef PG8_SCHED
}
}

typedef unsigned short bf16;
typedef float f32x4 __attribute__((ext_vector_type(4)));
typedef float f32x16 __attribute__((ext_vector_type(16)));
typedef short bf16x8 __attribute__((ext_vector_type(8)));
typedef unsigned u32x4 __attribute__((ext_vector_type(4)));
typedef unsigned u32x2 __attribute__((ext_vector_type(2)));
#define LAS __attribute__((address_space(3)))
#define DI __device__ __forceinline__

constexpr int DM = 2048, TX = 16384, NMETA = 16, NSAMP = 128, MROWS = 16640;
constexpr int ROW_SAMP = 16384, ROW_META = 16512, ROW_PAD = 16528;
constexpr int LRUW = 1024, INW = 7680, DFF = 8192, NWAVES = 8;
constexpr int C_XB = 0, C_YB = 1024, C_Q = 2048, C_K = 3072, C_V = 3328, C_GL = 3584, C_GA = 5632;
constexpr float RMS_EPS = 1e-6f, LOG2E = 1.4426950408889634f;
constexpr size_t O_Y = 0, O_YS = 33554432, O_MK = 33816576, O_MV = 33820672, O_WK = 33824768, O_WV = 33857536, O_CONV = 33890304, O_H = 33893376,
                 O_WKS = 33894400, O_WVS = 38088704, O_CONVS = 42283008, O_HS = 42676224, O_END = 42807296;
constexpr size_t MiB = 1u << 20;
constexpr size_t WS_WO = 1 * MiB, WS_WUP = 9 * MiB, WS_WDN = 41 * MiB, WS_WLRU = 73 * MiB, WS_WATT = 77 * MiB, WS_WG = 81 * MiB;
constexpr size_t WS_PROJ = 82 * MiB;
constexpr size_t WS_U = 82 * MiB;
constexpr size_t WS_B = 342 * MiB;
constexpr size_t WS_C = 407 * MiB;
constexpr size_t WS_WIN = WS_C, WS_VT = WS_C + 30 * MiB;
constexpr size_t WS_TAILF = 472 * MiB, WS_XTAIL = 474 * MiB, WS_AGG = 476 * MiB, WS_SS = 479 * MiB, WS_END = 480 * MiB;
constexpr int LDS_BYTES = 147456;

struct Args { const float* in[26]; float* out; unsigned char* ws; int ph_lo, ph_hi; };

DI float bf2f(bf16 x) { return __uint_as_float((unsigned)x << 16); }
DI float bflo(unsigned w) { return __uint_as_float(w << 16); }
DI float bfhi(unsigned w) { return __uint_as_float(w & 0xffff0000u); }
DI unsigned pk2(float lo, float hi) { return pg8::cvt_pk_bf16(lo, hi); }
DI float wave_sum(float v) {
#pragma unroll
    for (int o = 1; o < 64; o <<= 1) v += __shfl_xor(v, o);
    return v;
}
DI float wave_max(float v) {
#pragma unroll
    for (int o = 1; o < 64; o <<= 1) v = fmaxf(v, __shfl_xor(v, o));
    return v;
}
DI float sigm(float x) { return __builtin_amdgcn_rcpf(1.0f + __builtin_amdgcn_exp2f(-LOG2E * x)); }
DI float gelu_tanh(float x) {
    const float y = 0.7978845608028654f * (x + 0.044715f * x * x * x);
    return x * sigm(2.0f * y);
}
DI float neg_expm1(float x) {
    if (x > -0.125f) { float p = 1.0f / 720.0f; p = p * x + 1.0f / 120.0f; p = p * x + 1.0f / 24.0f; p = p * x + 1.0f / 6.0f; p = p * x + 0.5f; p = p * x + 1.0f; return -(p * x); }
    return 1.0f - __builtin_amdgcn_exp2f(LOG2E * x);
}

constexpr int P0_SCR = 64 * 65 * 4;
DI void p0_transpose64(const float* W, int N, bf16* WT, int ldT, int koff, const float* kscale, LAS float* scr, int kb, int nb, int lane) {
    const int k0 = 64 * kb, n0 = 64 * nb;
    const float* src = W + (size_t)k0 * N + n0 + lane;
    float v[64];
#pragma unroll
    for (int i = 0; i < 64; ++i) v[i] = src[(size_t)i * N];
    if (kscale) {
#pragma unroll
        for (int i = 0; i < 64; ++i) v[i] *= kscale[k0 + i]; }
#pragma unroll
    for (int i = 0; i < 64; ++i) scr[i * 65 + lane] = v[i];
    asm volatile("s_waitcnt lgkmcnt(0)" ::: "memory");
    const int c = lane & 7;
#pragma unroll
    for (int j = 0; j < 8; ++j) { const int n = (lane >> 3) + 8 * j; const LAS float* sp = scr + (8 * c) * 65 + n;
        u32x4 o; o.x = pk2(sp[0 * 65], sp[1 * 65]); o.y = pk2(sp[2 * 65], sp[3 * 65]); o.z = pk2(sp[4 * 65], sp[5 * 65]); o.w = pk2(sp[6 * 65], sp[7 * 65]);
        *(u32x4*)(WT + (size_t)(n0 + n) * ldT + koff + k0 + 8 * c) = o; }
    asm volatile("s_waitcnt lgkmcnt(0)" ::: "memory");
}
DI void p0_norm_rows2(const float* xr0, const float* xr1, const float* g, bf16* o0, bf16* o1, float* c0, float* c1, int lane) {
    f32x4 v[2][8]; float s0 = 0.f, s1 = 0.f;
#pragma unroll
    for (int j = 0; j < 8; ++j) { v[0][j] = xr0 ? *((const f32x4*)xr0 + lane + 64 * j) : (f32x4){0.f, 0.f, 0.f, 0.f}; v[1][j] = xr1 ? *((const f32x4*)xr1 + lane + 64 * j) : (f32x4){0.f, 0.f, 0.f, 0.f}; }
#pragma unroll
    for (int j = 0; j < 8; ++j) { s0 += (v[0][j].x * v[0][j].x + v[0][j].y * v[0][j].y) + (v[0][j].z * v[0][j].z + v[0][j].w * v[0][j].w);
                                  s1 += (v[1][j].x * v[1][j].x + v[1][j].y * v[1][j].y) + (v[1][j].z * v[1][j].z + v[1][j].w * v[1][j].w); }
    if (c0) {
#pragma unroll
        for (int j = 0; j < 8; ++j) *((f32x4*)c0 + lane + 64 * j) = v[0][j]; }
    if (c1) {
#pragma unroll
        for (int j = 0; j < 8; ++j) *((f32x4*)c1 + lane + 64 * j) = v[1][j]; }
    const float r0 = __builtin_amdgcn_rsqf(wave_sum(s0) * (1.0f / DM) + RMS_EPS), r1 = __builtin_amdgcn_rsqf(wave_sum(s1) * (1.0f / DM) + RMS_EPS);
#pragma unroll
    for (int j = 0; j < 8; ++j) { const f32x4 gg = *((const f32x4*)g + lane + 64 * j); const f32x4 a = v[0][j] * r0 * gg, b2 = v[1][j] * r1 * gg;
        u32x2 w; w.x = pk2(a.x, a.y); w.y = pk2(a.z, a.w); *((u32x2*)o0 + lane + 64 * j) = w;
        w.x = pk2(b2.x, b2.y); w.y = pk2(b2.z, b2.w); *((u32x2*)o1 + lane + 64 * j) = w; }
}

DI int crow(int r, int hi) { return (r & 3) + 8 * (r >> 2) + 4 * hi; }
constexpr int KS_STRIDE = 144, VT_STRIDE = 584, ATT_KS = 0, ATT_VT = 288 * KS_STRIDE  , ATT_LDS = ATT_VT + 64 * VT_STRIDE;
DI void attn_unit(LAS unsigned char* lds, const bf16* proj, const bf16* Vt, bf16* atto, const float* sinks, int qb, int g) {
    const int tid = threadIdx.x, lane = tid & 63, r32 = lane & 31, hi = lane >> 5; const int wave = __builtin_amdgcn_readfirstlane(tid >> 6);
    const int tok0 = 128 * (qb - 1);
    for (int i = tid; i < 288 * 8; i += 512) {
        const int kk = i >> 3, ch = i & 7; u32x4 v = (u32x4){0u, 0u, 0u, 0u};
        if (kk < 272) { int row = (kk < 256) ? tok0 + kk : ROW_META + (kk - 256); if (row < 0) row = 0;
            v = *(const u32x4*)(proj + (size_t)row * INW + C_K + g * 64 + ch * 8); }
        *(LAS u32x4*)(lds + ATT_KS + kk * KS_STRIDE + ch * 16) = v;
    }
    for (int i = tid; i < 64 * 36; i += 512) {
        const int d = i / 36, kc = i - d * 36; u32x4 v = (u32x4){0u, 0u, 0u, 0u};
        if (kc < 34) { const int row = (kc < 32) ? tok0 + 8 * kc : ROW_META + 8 * (kc - 32);
            if (row >= 0) v = *(const u32x4*)(Vt + (size_t)(g * 64 + d) * MROWS + row); }
        LAS u32x2* dst = (LAS u32x2*)(lds + ATT_VT + d * VT_STRIDE + kc * 16);
        dst[0] = (u32x2){v.x, v.y}; dst[1] = (u32x2){v.z, v.w};
    }
    __syncthreads();
    constexpr float C1 = 0.125f * LOG2E;
#pragma unroll 1
    for (int tsk = wave; tsk < 16; tsk += 8) {
        const int hh = tsk & 3, sl = tsk >> 2, h = 4 * g + hh;
        const float sl2 = __builtin_amdgcn_exp2f(-0.5f * (float)(h + 1)) * LOG2E;
        const float sink2 = sinks[h] * LOG2E;
        const int tok = 128 * qb + 32 * sl + r32;
        bf16x8 qf[4];
#pragma unroll
        for (int ks = 0; ks < 4; ++ks) qf[ks] = *(const bf16x8*)(proj + (size_t)tok * INW + C_Q + h * 64 + 16 * ks + 8 * hi);
        f32x16 S[6];
#pragma unroll
        for (int t = 0; t < 6; ++t) {
            const int base = (t < 5) ? 32 * (sl + t) : 256;
            f32x16 a = {};
#pragma unroll
            for (int ks = 0; ks < 4; ++ks) { const bf16x8 kf = *(const LAS bf16x8*)(lds + ATT_KS + (base + r32) * KS_STRIDE + (16 * ks + 8 * hi) * 2);
                a = __builtin_amdgcn_mfma_f32_32x32x16_bf16(kf, qf[ks], a, 0, 0, 0); }
            S[t] = a; __builtin_amdgcn_sched_barrier(0);
        }
        int rb = r32 - 4 * hi; asm volatile("" : "+v"(rb));
        const float negb = -sl2 * (float)rb;
        float mx = sink2;
#pragma unroll
        for (int t = 0; t < 6; ++t) {
            const bool tile_dead = (t < 5) && (qb == 0) && (sl + t < 4);
#pragma unroll
            for (int r = 0; r < 16; ++r) {
                const int cc = (r & 3) + 8 * (r >> 2);
                float v; bool ok;
                if (t < 5) { v = fmaf(S[t][r], C1, fmaf(-sl2, (float)(128 - 32 * t - cc), negb));
                             ok = !tile_dead && (t != 0 || rb <= cc) && (t != 4 || cc <= rb); }
                else { v = S[t][r] * C1; ok = (r < 8); }
                v = ok ? v : -1e30f; S[t][r] = v; mx = fmaxf(mx, v);
            }
        }
        mx = fmaxf(mx, __shfl_xor(mx, 32));
        float sum = 0.f;
#pragma unroll
        for (int t = 0; t < 6; ++t)
#pragma unroll
            for (int r = 0; r < 16; ++r) { const float e = __builtin_amdgcn_exp2f(S[t][r] - mx); S[t][r] = e; sum += e; }
        sum += __shfl_xor(sum, 32);
        const float inv = 1.0f / (sum + __builtin_amdgcn_exp2f(sink2 - mx));
        f32x16 O[2]; O[0] = (f32x16){}; O[1] = (f32x16){};
#pragma unroll
        for (int t = 0; t < 6; ++t) {
            const int base = (t < 5) ? 32 * (sl + t) : 256;
#pragma unroll
            for (int ks = 0; ks < 2; ++ks) {
                u32x4 pw; pw.x = pk2(S[t][8 * ks + 0] * inv, S[t][8 * ks + 1] * inv); pw.y = pk2(S[t][8 * ks + 2] * inv, S[t][8 * ks + 3] * inv);
                pw.z = pk2(S[t][8 * ks + 4] * inv, S[t][8 * ks + 5] * inv); pw.w = pk2(S[t][8 * ks + 6] * inv, S[t][8 * ks + 7] * inv);
                const bf16x8 pb = __builtin_bit_cast(bf16x8, pw);
#pragma unroll
                for (int dt = 0; dt < 2; ++dt) {
                    const LAS unsigned char* vp = lds + ATT_VT + (r32 + 32 * dt) * VT_STRIDE + (base + 16 * ks + 4 * hi) * 2;
                    const u32x2 v0 = *(const LAS u32x2*)vp, v1 = *(const LAS u32x2*)(vp + 16);
                    const u32x4 vw = (u32x4){v0.x, v0.y, v1.x, v1.y};
                    O[dt] = __builtin_amdgcn_mfma_f32_32x32x16_bf16(__builtin_bit_cast(bf16x8, vw), pb, O[dt], 0, 0, 0);
                }
                __builtin_amdgcn_sched_barrier(0);
            }
        }
        bf16* op = atto + (size_t)tok * 2048 + h * 64;
#pragma unroll
        for (int dt = 0; dt < 2; ++dt)
#pragma unroll
            for (int gq = 0; gq < 4; ++gq) { u32x2 w; w.x = pk2(O[dt][4 * gq + 0], O[dt][4 * gq + 1]); w.y = pk2(O[dt][4 * gq + 2], O[dt][4 * gq + 3]);
                *(u32x2*)(op + 32 * dt + 8 * gq + 4 * hi) = w; }
    }
    __syncthreads();
}

constexpr int SA_HALF = 24576, SA_SC = 1024, SA_RED = 4096;
DI void sample_attn_item(LAS unsigned char* lds, const bf16* proj, const float* cmk, const float* cmv, const float* cwk, const float* cwv, const float* sinks,
                         bf16* atto, float* out_wk, float* out_wv, int b, int gp) {
    const int tid = threadIdx.x, th = tid & 255, lane = tid & 63; const int half = __builtin_amdgcn_readfirstlane(tid >> 8);
    const int g = 2 * gp + half;
    LAS unsigned char* hl = lds + half * SA_HALF;
    LAS float* qs = (LAS float*)hl; LAS float* sc = (LAS float*)(hl + SA_SC); LAS float* red = (LAS float*)(hl + SA_RED);
    const size_t row = (size_t)(ROW_SAMP + b);
    { const int hh = th >> 6, d = th & 63; qs[hh * 64 + d] = bf2f(proj[row * INW + C_Q + (4 * g + hh) * 64 + d]); }
    __syncthreads();
    const int d4 = th & 15, jg = th >> 4;
    float sl[4];
#pragma unroll
    for (int hh = 0; hh < 4; ++hh) sl[hh] = __builtin_amdgcn_exp2f(-0.5f * (float)(4 * g + hh + 1));
    {
        f32x4 kv[9];
#pragma unroll
        for (int m = 0; m < 9; ++m) { const int j = jg + 16 * m;
            const float* kp = (j < 16) ? cmk + ((size_t)(b * 16 + j) * 4 + g) * 64 : cwk + ((size_t)(b * 128 + (j - 16)) * 4 + g) * 64;
            kv[m] = *((const f32x4*)kp + d4); }
        f32x4 qv[4];
#pragma unroll
        for (int hh = 0; hh < 4; ++hh) qv[hh] = *(const LAS f32x4*)(qs + hh * 64 + 4 * d4);
#pragma unroll
        for (int m = 0; m < 9; ++m) { const int j = jg + 16 * m;
            if (j >= 17) *((f32x4*)(out_wk + ((size_t)(b * 128 + (j - 17)) * 4 + g) * 64) + d4) = kv[m];
            const float dist = (j < 16) ? 0.f : (float)(144 - j);
#pragma unroll
            for (int hh = 0; hh < 4; ++hh) { float sdot = qv[hh].x * kv[m].x + qv[hh].y * kv[m].y + qv[hh].z * kv[m].z + qv[hh].w * kv[m].w;
                sdot += __shfl_xor(sdot, 1); sdot += __shfl_xor(sdot, 2); sdot += __shfl_xor(sdot, 4); sdot += __shfl_xor(sdot, 8);
                if (d4 == 0) sc[hh * 160 + j] = sdot * 0.125f - sl[hh] * dist; } }
        const u32x2 w = *((const u32x2*)(proj + row * INW + C_K + g * 64) + d4); const f32x4 kn = (f32x4){bflo(w.x), bfhi(w.x), bflo(w.y), bfhi(w.y)};
        if (th < 16) *((f32x4*)(out_wk + ((size_t)(b * 128 + 127) * 4 + g) * 64) + d4) = kn;
#pragma unroll
        for (int hh = 0; hh < 4; ++hh) { float sdot = qv[hh].x * kn.x + qv[hh].y * kn.y + qv[hh].z * kn.z + qv[hh].w * kn.w;
            sdot += __shfl_xor(sdot, 1); sdot += __shfl_xor(sdot, 2); sdot += __shfl_xor(sdot, 4); sdot += __shfl_xor(sdot, 8);
            if (th == 0) sc[hh * 160 + 144] = sdot * 0.125f; }
    }
    __syncthreads();
    {
        const int hh = th >> 6; const float sink = sinks[4 * g + hh];
        float v[3]; float mx = sink;
#pragma unroll
        for (int rr = 0; rr < 3; ++rr) { const int j = lane + 64 * rr; v[rr] = (j < 145) ? sc[hh * 160 + j] : -1e30f; mx = fmaxf(mx, v[rr]); }
        mx = wave_max(mx);
        float sum = 0.f;
#pragma unroll
        for (int rr = 0; rr < 3; ++rr) { v[rr] = __builtin_amdgcn_exp2f((v[rr] - mx) * LOG2E); sum += v[rr]; }
        sum = wave_sum(sum);
        const float inv = 1.0f / (sum + __builtin_amdgcn_exp2f((sink - mx) * LOG2E));
#pragma unroll
        for (int rr = 0; rr < 3; ++rr) { const int j = lane + 64 * rr; if (j < 145) sc[hh * 160 + j] = v[rr] * inv; }
    }
    __syncthreads();
    {
        f32x4 vv[9];
#pragma unroll
        for (int m = 0; m < 9; ++m) { const int j = jg + 16 * m;
            const float* vp = (j < 16) ? cmv + ((size_t)(b * 16 + j) * 4 + g) * 64 : cwv + ((size_t)(b * 128 + (j - 16)) * 4 + g) * 64;
            vv[m] = *((const f32x4*)vp + d4); }
        f32x4 o[4]; o[0] = o[1] = o[2] = o[3] = (f32x4){0.f, 0.f, 0.f, 0.f};
#pragma unroll
        for (int m = 0; m < 9; ++m) { const int j = jg + 16 * m;
            if (j >= 17) *((f32x4*)(out_wv + ((size_t)(b * 128 + (j - 17)) * 4 + g) * 64) + d4) = vv[m];
#pragma unroll
            for (int hh = 0; hh < 4; ++hh) o[hh] += vv[m] * sc[hh * 160 + j]; }
        if (th < 16) { const u32x2 w = *((const u32x2*)(proj + row * INW + C_V + g * 64) + d4); const f32x4 vn = (f32x4){bflo(w.x), bfhi(w.x), bflo(w.y), bfhi(w.y)};
            *((f32x4*)(out_wv + ((size_t)(b * 128 + 127) * 4 + g) * 64) + d4) = vn;
#pragma unroll
            for (int hh = 0; hh < 4; ++hh) o[hh] += vn * sc[hh * 160 + 144]; }
#pragma unroll
        for (int hh = 0; hh < 4; ++hh) *(LAS f32x4*)(red + (jg * 16 + d4) * 16 + hh * 4) = o[hh];
    }
    __syncthreads();
    { const int hh = th >> 6, d = th & 63; float acc = 0.f;
#pragma unroll
      for (int grp = 0; grp < 16; ++grp) acc += red[(grp * 16 + (d >> 2)) * 16 + hh * 4 + (d & 3)];
      atto[row * 2048 + (4 * g + hh) * 64 + d] = (bf16)(pk2(acc, 0.f) & 0xffffu); }
    __syncthreads();
}

constexpr int SK_KC = 512, SK_STRIDE = 1040, SK_BUF = 32 * SK_STRIDE;
template <class F, class MF> DI void skinny_task(LAS unsigned char* lds, const bf16* A, int lda, const bf16* Wt, int ldw, int n0, int k0, int klen, int mid_chunk  , MF midf, F epi) {
    const int tid = threadIdx.x, lane = tid & 63, l15 = lane & 15, kq = lane >> 4; const int wave = __builtin_amdgcn_readfirstlane(tid >> 6);
    typedef float f32x4v __attribute__((ext_vector_type(4)));
    const int wcol = tid >> 4, wpart = tid & 15;
    const bf16* wsrc = Wt + (size_t)(n0 + wcol) * ldw + k0 + wpart * 8;
    const bf16* asrc = A + (size_t)(16 * wave + l15) * lda + k0 + 8 * kq;
    const int nch = klen / SK_KC;
    u32x4 wreg[4];
#pragma unroll
    for (int i = 0; i < 4; ++i) wreg[i] = *(const u32x4*)(wsrc + i * 128);
#pragma unroll
    for (int i = 0; i < 4; ++i) *(LAS u32x4*)(lds + wcol * SK_STRIDE + (wpart + 16 * i) * 16) = wreg[i];
    __syncthreads();
    f32x4v acc0 = {0.f, 0.f, 0.f, 0.f}, acc1 = {0.f, 0.f, 0.f, 0.f};
#pragma unroll 1
    for (int c = 0; c < nch; ++c) {
        const bool more = (c + 1 < nch);
        if (c == mid_chunk) {
#pragma unroll
            for (int r = 0; r < 4; ++r) { const int row = 16 * wave + 4 * kq + r; acc0[r] = midf(row, n0 + l15, acc0[r]); acc1[r] = midf(row, n0 + 16 + l15, acc1[r]); } }
        if (more) {
#pragma unroll
            for (int i = 0; i < 4; ++i) wreg[i] = *(const u32x4*)(wsrc + (size_t)(c + 1) * SK_KC + i * 128); }
        bf16x8 af[16];
#pragma unroll
        for (int sI = 0; sI < 16; ++sI) af[sI] = *(const bf16x8*)(asrc + (size_t)c * SK_KC + 32 * sI);
        const LAS unsigned char* wb = lds + (c & 1) * SK_BUF;
#pragma unroll
        for (int sI = 0; sI < 16; ++sI) {
            const bf16x8 b0 = *(const LAS bf16x8*)(wb + l15 * SK_STRIDE + (32 * sI + 8 * kq) * 2);
            const bf16x8 b1 = *(const LAS bf16x8*)(wb + (16 + l15) * SK_STRIDE + (32 * sI + 8 * kq) * 2);
            acc0 = __builtin_amdgcn_mfma_f32_16x16x32_bf16(af[sI], b0, acc0, 0, 0, 0);
            acc1 = __builtin_amdgcn_mfma_f32_16x16x32_bf16(af[sI], b1, acc1, 0, 0, 0);
        }
        if (more) {
#pragma unroll
            for (int i = 0; i < 4; ++i) *(LAS u32x4*)(lds + ((c + 1) & 1) * SK_BUF + wcol * SK_STRIDE + (wpart + 16 * i) * 16) = wreg[i]; }
        __syncthreads();
    }
#pragma unroll
    for (int r = 0; r < 4; ++r) { const int row = 16 * wave + 4 * kq + r; epi(row, n0 + l15, acc0[r]); epi(row, n0 + 16 + l15, acc1[r]); }
}

constexpr int LRU_G = 0;
constexpr int LRU_XCB = 65536;
constexpr int LRU_COMP = 82944;
constexpr int LRU_HST = 87040;
constexpr int LRU_LDS = 88064;
struct LruP { const bf16* proj; const bf16* wg; const float* conv_w; const float* conv_b; const float* bgx; const float* bga; const float* aparam;
              const float* state_conv; const float* state_h; float* agg; bf16* lruo; float* out_hs; float* out_h; };
DI int lru_ext_row(int seqc, int t) {
    if (seqc == 0) return (t >= 0 && t < 16) ? ROW_META + t : -1;
    const int tokn = 64 * (seqc - 1) + t; return (tokn >= 0) ? tokn : ROW_META + 16 + tokn;
}
template <int MODE>
DI void lru_run(LAS unsigned char* lds, const LruP& P, int n, int r) {
    const int tid = threadIdx.x, lane = tid & 63; const int wave = __builtin_amdgcn_readfirstlane(tid >> 6);
    typedef float f32x2v __attribute__((ext_vector_type(2)));
    LAS float* G = (LAS float*)(lds + LRU_G); LAS float* XE = G; LAS f32x2v* COMP = (LAS f32x2v*)(lds + LRU_COMP); LAS float* HST = (LAS float*)(lds + LRU_HST);
    const int ch = tid & 127, cg = n * 128 + ch; const int seg = __builtin_amdgcn_readfirstlane(tid >> 7);
    const int r32 = lane & 31, hi = lane >> 5;
    bf16x8 bw[8];
    { const bf16* wp = P.wg + ((size_t)(n * 256 + 32 * wave + r32)) * 128 + 8 * hi;
#pragma unroll
      for (int ks = 0; ks < 8; ++ks) bw[ks] = *(const bf16x8*)(wp + 16 * ks); }
    const float w0 = P.conv_w[0 * LRUW + cg], w1 = P.conv_w[1 * LRUW + cg], w2 = P.conv_w[2 * LRUW + cg], w3 = P.conv_w[3 * LRUW + cg], cb = P.conv_b[cg];
    const int gcol = 32 * wave + r32;
    const float gbias = (wave < 4) ? P.bgx[n * 128 + gcol] : P.bga[n * 128 + gcol - 128];
    const float ap = P.aparam[cg]; const float ex = __expf(-ap);
    const float sp = (ex < 0.03f) ? ex * (1.0f - ex * (0.5f - ex * (0.333333333f - ex * (0.25f - ex * 0.2f)))) : logf(1.0f + ex);
    const int nunits = (MODE == 2) ? 1 : (r == 0 ? 9 : 8);
    const int seq0 = (MODE == 2) ? 0 : (r == 0 ? 0 : 8 * r + 1);
    float Pc = 1.f, Hc = 0.f;
    if (MODE == 1) {
        if (tid < 128) { float h = 0.f; float a_[32], b_[32];
#pragma unroll
            for (int q = 0; q < 32; ++q) { a_[q] = 1.f; b_[q] = 0.f; if (q < r) { a_[q] = P.agg[((size_t)q * 2 + 0) * LRUW + cg]; b_[q] = P.agg[((size_t)q * 2 + 1) * LRUW + cg]; } }
#pragma unroll
            for (int q = 0; q < 32; ++q) h = a_[q] * h + b_[q];
            HST[tid] = h; }
    }
    u32x4 xe_n[3];
#define LRU_PREFETCH(seqc_) do { \
        _Pragma("unroll") for (int q_ = 0; q_ < 3; ++q_) { const int i_ = tid + 512 * q_; xe_n[q_] = (u32x4){0u, 0u, 0u, 0u}; \
            if (i_ < 67 * 16) { const int row_ = lru_ext_row((seqc_), (i_ >> 4) - 3); if (row_ >= 0) xe_n[q_] = *(const u32x4*)(P.proj + (size_t)row_ * INW + C_XB + n * 128 + (i_ & 15) * 8); } } \
        } while (0)
    if (MODE != 2) LRU_PREFETCH(seq0);
#pragma unroll 1
    for (int j = 0; j < nunits; ++j) {
        int tid_o = tid; asm volatile("" : "+v"(tid_o));
        const int ch = tid_o & 127, cg = n * 128 + ch, r32 = tid_o & 31, hi = (tid_o >> 5) & 1, gcol = 32 * wave + r32;
        const int seqc = seq0 + j;
        const int nrows = (MODE != 2 && seqc == 0) ? 16 : 64;
        float yv[16];
        if (MODE == 1) {
            const bf16* yp = P.proj + (size_t)((seqc > 0 ? 64 * (seqc - 1) : 0) + 16 * seg) * INW + C_YB + cg;
#pragma unroll
            for (int k = 0; k < 16; ++k) yv[k] = bf2f(yp[(size_t)k * INW]); }
        if (MODE == 2) {
#pragma unroll
            for (int k = 0; k < 16; ++k) yv[k] = bf2f(P.proj[(size_t)(ROW_SAMP + 64 * r + 16 * seg + k) * INW + C_YB + cg]); }
        if (MODE != 2) {
#pragma unroll
            for (int q = 0; q < 3; ++q) { const int i = tid + 512 * q; if (i < 67 * 16) { const int e = i >> 4, c8 = (i & 15) * 8; const u32x4 v = xe_n[q];
                *(LAS f32x4*)(XE + e * 128 + c8) = (f32x4){bflo(v.x), bfhi(v.x), bflo(v.y), bfhi(v.y)};
                *(LAS f32x4*)(XE + e * 128 + c8 + 4) = (f32x4){bflo(v.z), bfhi(v.z), bflo(v.w), bfhi(v.w)}; } }
            __syncthreads();
            if (j + 1 < nunits) LRU_PREFETCH(seqc + 1);
        }
        float xc[16];
        if (MODE != 2) {
            float x0 = XE[(16 * seg + 0) * 128 + ch], x1 = XE[(16 * seg + 1) * 128 + ch], x2 = XE[(16 * seg + 2) * 128 + ch];
#pragma unroll
            for (int k = 0; k < 16; ++k) { const float x3 = XE[(16 * seg + k + 3) * 128 + ch]; xc[k] = w0 * x0 + w1 * x1 + w2 * x2 + w3 * x3 + cb; x0 = x1; x1 = x2; x2 = x3; }
        } else {
#pragma unroll
            for (int k = 0; k < 16; ++k) { const int t = 16 * seg + k; const int b = 64 * r + t; const float* scp = P.state_conv + (size_t)b * 3 * LRUW + cg;
                xc[k] = w0 * scp[0] + w1 * scp[LRUW] + w2 * scp[2 * LRUW] + w3 * bf2f(P.proj[(size_t)(ROW_SAMP + b) * INW + C_XB + cg]) + cb; }
        }
#pragma unroll
        for (int k = 0; k < 16; ++k) { const int t = 16 * seg + k; if (t >= nrows) xc[k] = 0.f;
            *(LAS bf16*)(lds + LRU_XCB + t * 272 + ch * 2) = (bf16)(pk2(xc[k], 0.f) & 0xffffu); }
        __syncthreads();
        { f32x16 acc0 = {}, acc1 = {};
#pragma unroll
          for (int ks = 0; ks < 8; ++ks) {
              const bf16x8 a0 = *(const LAS bf16x8*)(lds + LRU_XCB + r32 * 272 + (16 * ks + 8 * hi) * 2);
              const bf16x8 a1 = *(const LAS bf16x8*)(lds + LRU_XCB + (r32 + 32) * 272 + (16 * ks + 8 * hi) * 2);
              acc0 = __builtin_amdgcn_mfma_f32_32x32x16_bf16(a0, bw[ks], acc0, 0, 0, 0);
              acc1 = __builtin_amdgcn_mfma_f32_32x32x16_bf16(a1, bw[ks], acc1, 0, 0, 0);
          }
#pragma unroll
          for (int q = 0; q < 16; ++q) { const int t = crow(q, hi); G[t * 256 + gcol] = sigm(acc0[q] + gbias); G[(t + 32) * 256 + gcol] = sigm(acc1[q] + gbias); }
        }
        __syncthreads();
        float av[16], bv[16];
#pragma unroll
        for (int k = 0; k < 16; ++k) { const int t = 16 * seg + k;
            const float gx = G[t * 256 + ch], ga = G[t * 256 + 128 + ch];
            const float loga = -8.0f * ga * sp; av[k] = __builtin_amdgcn_exp2f(LOG2E * loga); bv[k] = sqrtf(neg_expm1(2.0f * loga)) * gx * xc[k];
            if (MODE != 2 && t >= nrows) { av[k] = 1.f; bv[k] = 0.f; } }
        if (MODE == 2) {
#pragma unroll
            for (int k = 0; k < 16; ++k) { const int t = 16 * seg + k; const int b = 64 * r + t;
                const float h = av[k] * P.state_h[(size_t)b * LRUW + cg] + bv[k]; P.out_hs[(size_t)b * LRUW + cg] = h;
                P.lruo[(size_t)(ROW_SAMP + b) * 2048 + cg] = (bf16)(pk2(gelu_tanh(yv[k]) * h, 0.f) & 0xffffu); }
        } else {
            { float p = 1.f, h = 0.f;
#pragma unroll
              for (int k = 0; k < 16; ++k) { h = av[k] * h + bv[k]; p *= av[k]; }
              COMP[seg * 128 + ch] = (f32x2v){p, h}; }
            __syncthreads();
            if (MODE == 0) {
                if (seg == 3) {
#pragma unroll
                    for (int sI = 0; sI < 4; ++sI) { const f32x2v c = COMP[sI * 128 + ch]; Hc = c.x * Hc + c.y; Pc *= c.x; } }
            } else {
                float h = HST[(j & 1) * 128 + ch];
                for (int sI = 0; sI < seg; ++sI) { const f32x2v c = COMP[sI * 128 + ch]; h = c.x * h + c.y; }
                if (seqc > 0) {
                    bf16* op = P.lruo + (size_t)(64 * (seqc - 1) + 16 * seg) * 2048 + cg;
#pragma unroll
                    for (int k = 0; k < 16; ++k) { h = av[k] * h + bv[k]; op[(size_t)k * 2048] = (bf16)(pk2(gelu_tanh(yv[k]) * h, 0.f) & 0xffffu); }
                } else {
#pragma unroll
                    for (int k = 0; k < 16; ++k) h = av[k] * h + bv[k];
                }
                if (seg == 3) HST[((j + 1) & 1) * 128 + ch] = h;
            }
        }
    }
#undef LRU_PREFETCH
    if (MODE == 0 && seg == 3) { P.agg[((size_t)r * 2 + 0) * LRUW + cg] = Pc; P.agg[((size_t)r * 2 + 1) * LRUW + cg] = Hc; }
    if (MODE == 1 && seg == 3 && r == 31) P.out_h[cg] = HST[(nunits & 1) * 128 + ch];
    __syncthreads();
}

#define RLX_AGENT __ATOMIC_RELAXED, __HIP_MEMORY_SCOPE_AGENT
#define XB_TMO      128
#define XB_XCNT(j)  (256  + 64 * (j))
#define XB_XSUB(j)  (1280 + 64 * (j))
#define XB_XGEN(j)  (2304 + 64 * (j))
#define XB_TOP      3328
#define XB_TOPGEN   3392
#define XCD_BAR_WORDS 3456
#define XB_SPIN_CAP (1u << 18)
DI unsigned xb_ld(unsigned* p)              { return __hip_atomic_load(p, __ATOMIC_RELAXED, __HIP_MEMORY_SCOPE_AGENT); }
DI unsigned xb_add(unsigned* p, unsigned v) { return __hip_atomic_fetch_add(p, v, __ATOMIC_RELAXED, __HIP_MEMORY_SCOPE_AGENT); }
DI unsigned xb_xcc_id() { return (unsigned)__builtin_amdgcn_s_getreg((3 << 11) | 20) & 0xFu; }
#define XB_SPIN(cond, bar) do { unsigned _sp = 0; while (cond) { __builtin_amdgcn_s_sleep(1); \
    if ((++_sp & 255u) == 0u) { if (xb_ld(&(bar)[XB_TMO])) break; if (_sp > XB_SPIN_CAP) { atomicAdd(&(bar)[XB_TMO], 1u); break; } } } } while (0)
struct XcdBarrier { unsigned* bar; unsigned x; volatile LAS unsigned* st; };
DI XcdBarrier xcd_barrier_post(unsigned* bar, volatile LAS unsigned* st) {
    XcdBarrier b; b.bar = bar; b.x = xb_xcc_id(); b.st = st;
    if (threadIdx.x == 0) (void)xb_add(&bar[XB_XCNT(b.x)], 1u);
    return b;
}
DI void xcd_barrier_complete(unsigned* bar, unsigned x, unsigned& nloc, unsigned& nx) {
    const unsigned Gn = gridDim.x * gridDim.y * gridDim.z;
    unsigned sum, cnt, mine, sp = 0u;
    for (;;) {
        sum = 0u; cnt = 0u; mine = 0u;
#pragma unroll
        for (unsigned j = 0; j < 16; ++j) { const unsigned c = xb_ld(&bar[XB_XCNT(j)]); sum += c; cnt += (c > 0u) ? 1u : 0u; mine = (j == x) ? c : mine; }
        if (sum == Gn) break;
        __builtin_amdgcn_s_sleep(1);
        if ((++sp & 255u) == 0u) { if (xb_ld(&bar[XB_TMO])) break; if (sp > XB_SPIN_CAP) { atomicAdd(&bar[XB_TMO], 1u); break; } }
    }
    nloc = mine > 0u ? mine : 1u; nx = cnt > 0u ? cnt : 1u;
}
DI void xcd_barrier(const XcdBarrier& b) {
    asm volatile("s_waitcnt vmcnt(0)" ::: "memory");
    __syncthreads();
    if (threadIdx.x == 0) {
        unsigned* bar = b.bar;
        __builtin_amdgcn_s_waitcnt(0);
        unsigned nloc = b.st[0], nx = b.st[1];
        if (nloc == 0u) { xcd_barrier_complete(bar, b.x, nloc, nx); b.st[0] = nloc; b.st[1] = nx; }
        const unsigned old = xb_add(&bar[XB_XSUB(b.x)], 1u);
        const unsigned gen = old / nloc;
        if (old + 1u == (gen + 1u) * nloc) {
            __builtin_amdgcn_fence(__ATOMIC_RELEASE, "agent");
            asm volatile("s_waitcnt vmcnt(0)" ::: "memory");
            const unsigned og = xb_add(&bar[XB_TOP], 1u);
            const unsigned tg = og / nx;
            if (og + 1u == (tg + 1u) * nx) xb_add(&bar[XB_TOPGEN], 1u);
            else XB_SPIN(xb_ld(&bar[XB_TOPGEN]) == tg, bar);
            __builtin_amdgcn_fence(__ATOMIC_ACQUIRE, "agent");
            xb_add(&bar[XB_XGEN(b.x)], 1u);
            asm volatile("s_waitcnt vmcnt(0)" ::: "memory");
        } else {
            XB_SPIN(xb_ld(&bar[XB_XGEN(b.x)]) == gen, bar);
            __builtin_amdgcn_fence(__ATOMIC_ACQUIRE, "agent");
            asm volatile("s_waitcnt vmcnt(0)" ::: "memory");
        }
    }
    __syncthreads();
}
constexpr int MISC_OFF = 147456 - 128;
constexpr size_t WS_CTL = 0, CTL_ZERO_BYTES = 65536;
constexpr int CW_BAR = 4096;

typedef const Args __attribute__((address_space(4)))* KArgs;
#define KA() ({ KArgs p_ = (KArgs)__builtin_amdgcn_kernarg_segment_ptr(); asm volatile("" : "+s"(p_)); p_; })
__global__ void __launch_bounds__(NWAVES * 64, 2) griffin_fwd(Args args) {
    extern __shared__ __attribute__((aligned(16))) unsigned char lds_raw[];
    LAS unsigned char* lds = (LAS unsigned char*)lds_raw;
    const int tid = threadIdx.x, lane = tid & 63; const int wave = __builtin_amdgcn_readfirstlane(tid >> 6);
#define G ((int)gridDim.x)
#define bx ((int)blockIdx.x)
#define gw (bx * NWAVES + wave)
#define NGW (G * NWAVES)
#define ws (ka->ws)
#define out (ka->out)
#define x_prompt (ka->in[0])
#define x_sample (ka->in[1])
#define Wo_t ((bf16*)(ws + WS_WO))
#define Wup_t ((bf16*)(ws + WS_WUP))
#define Wdn_t ((bf16*)(ws + WS_WDN))
#define Wmix_t ((bf16*)(ws + WS_WLRU))
#define Wg_t ((bf16*)(ws + WS_WG))
#define Win_t ((bf16*)(ws + WS_WIN))
#define XN ((bf16*)(ws + WS_B))
#define PROJ ((bf16*)(ws + WS_PROJ))
#define VT ((bf16*)(ws + WS_VT))
#define MIX ((bf16*)(ws + WS_B))
#define MERGED ((bf16*)(ws + WS_C))
#define HB ((bf16*)(ws + WS_B))
#define UB ((bf16*)(ws + WS_U))
#define TAILF ((float*)(ws + WS_TAILF))
#define XTAIL ((float*)(ws + WS_XTAIL))
#define AGG ((float*)(ws + WS_AGG))
#define SS ((float*)(ws + WS_SS))
#define PART ((float*)(ws + WS_C))
    int lo, hi_ph; { const KArgs ka = KA(); lo = ka->ph_lo; hi_ph = ka->ph_hi; }
#if MK_N_LAUNCHES == 1 && !defined(ALL_CG_SYNC)
    if (tid < 32) ((LAS unsigned*)(lds + MISC_OFF))[tid] = 0u;
    __syncthreads();
    XcdBarrier xbar; { const KArgs ka = KA(); xbar = xcd_barrier_post((unsigned*)(ws + WS_CTL) + CW_BAR, (volatile LAS unsigned*)(lds + MISC_OFF) + 8); }
#endif
#ifndef DUP_PHASE
#define DUP_PHASE -1
#endif
#ifndef P2_PARTS
#define P2_PARTS 31
#endif
#ifndef PH_MASK
#define PH_MASK 0x1ff
#endif
#define IN(k) (((PH_MASK >> (k)) & 1) && lo <= (k) && (k) < hi_ph)
#if MK_N_LAUNCHES == 1
#if defined(ALL_CG_SYNC)
#define GRID_BAR(k) do { if (IN(k) && IN((k) + 1)) { cg::this_grid().sync(); } } while (0)
#elif defined(PLAIN_LAUNCH)
#define GRID_BAR(k) do { if (IN(k) && IN((k) + 1)) { xcd_barrier(xbar); } } while (0)
#else
#define GRID_BAR(k) do { if (IN(k) && IN((k) + 1)) { if ((k) == 0) cg::this_grid().sync(); else xcd_barrier(xbar); } } while (0)
#endif
#else
#define GRID_BAR(k) do { } while (0)
#endif

    if (IN(0)) {
        const KArgs ka = KA();
        LAS float* scr = (LAS float*)(lds + wave * P0_SCR);
        constexpr int I_IN = 32 * 120, I_O = 32 * 32, I_UP = 32 * 128, I_DN = 128 * 32, I_L = 16 * 32, I_G = 64;
        constexpr int NITEMS = I_IN + I_O + I_UP + I_DN + 2 * I_L + I_G;
        for (int it = gw; it < NITEMS; it += NGW) {
            int r = it;
            if (r < I_IN) { p0_transpose64(ka->in[10], INW, Win_t, DM, 0, nullptr, scr, r / 120, r % 120, lane); continue; } r -= I_IN;
            if (r < I_O) { p0_transpose64(ka->in[21], DM, Wo_t, DM, 0, nullptr, scr, r >> 5, r & 31, lane); continue; } r -= I_O;
            if (r < I_UP) { p0_transpose64(ka->in[23], DFF, Wup_t, DM, 0, ka->in[22], scr, r >> 7, r & 127, lane); continue; } r -= I_UP;
            if (r < I_DN) { p0_transpose64(ka->in[24], DM, Wdn_t, DFF, 0, nullptr, scr, r >> 5, r & 31, lane); continue; } r -= I_DN;
            if (r < I_L) { p0_transpose64(ka->in[20], DM, Wmix_t, DM, 0, nullptr, scr, r >> 5, r & 31, lane); continue; } r -= I_L;
            if (r < I_L) { p0_transpose64(ka->in[19], DM, Wmix_t, DM, 1024, nullptr, scr, r >> 5, r & 31, lane); continue; } r -= I_L;
            { const int nb = r >> 3, which = (r >> 2) & 1, sub = r & 3;
              p0_transpose64((which ? ka->in[15] : ka->in[13]) + (size_t)nb * 128 * 128, 128, Wg_t + (size_t)nb * 256 * 128 + (size_t)which * 128 * 128, 128, 0, nullptr, scr, sub >> 1, sub & 1, lane); }
        }
        for (int m2 = gw; m2 < MROWS / 2; m2 += NGW) {
            const float* xr[2];
#pragma unroll
            for (int q = 0; q < 2; ++q) { const int m = 2 * m2 + q;
                xr[q] = (m < TX) ? x_prompt + (size_t)m * DM : (m < ROW_META) ? x_sample + (size_t)(m - ROW_SAMP) * DM : (m < ROW_PAD) ? ka->in[8] + (size_t)(m - ROW_META) * DM : nullptr; }
            const int m = 2 * m2;
            p0_norm_rows2(xr[0], xr[1], ka->in[9], XN + (size_t)m * DM, XN + (size_t)(m + 1) * DM, (m >= TX) ? XTAIL + (size_t)(m - TX) * DM : nullptr, (m >= TX) ? XTAIL + (size_t)(m + 1 - TX) * DM : nullptr, lane);
        }
        for (int i = bx * 512 + tid; i < MROWS; i += G * 512) SS[i] = 0.f;
    }
    GRID_BAR(0);

    if (IN(1)) {
        const KArgs ka = KA();
        pg8::Gemm g{XN, Win_t, MROWS, INW, DM};
        pg8::ProjOrder S; S.init(MROWS, INW, G, bx); S.n1 = MROWS / 256; S.vtile = C_V / 256;
        pg8::EpiProj E{PROJ, INW, VT, MROWS};
        pg8::gemm_phase<pg8::EpiProj, pg8::ProjOrder, true, true>(lds, g, S, E);
    }
    GRID_BAR(1);

    if (IN(2)) {
        const KArgs ka = KA();
        if (P2_PARTS & 1) for (int u = bx; u < 512; u += G) attn_unit(lds, PROJ, VT, MIX, ka->in[18], u >> 2, u & 3);
        LruP LP{PROJ, Wg_t, ka->in[11], ka->in[12], ka->in[14], ka->in[16], ka->in[17], ka->in[6], ka->in[7], AGG, MIX + 1024, out + O_HS, out + O_H};
        if (P2_PARTS & 2) lru_run<0>(lds, LP, bx & 7, bx >> 3);
        if (P2_PARTS & 4) { const int u = bx - (G - 16); if (u >= 0) lru_run<2>(lds, LP, u & 7, u >> 3); }
        if (P2_PARTS & 8) for (int u = bx; u < 256; u += G) sample_attn_item(lds, PROJ, ka->in[2], ka->in[3], ka->in[4], ka->in[5], ka->in[18], MIX, out + O_WKS, out + O_WVS, u >> 1, u & 1);
        const int gt = bx * 512 + tid, NT = G * 512;
        for (int i = gt; i < 16 * 256; i += NT) { const int r = i >> 8, c = i & 255; out[O_MK + i] = bf2f(PROJ[(size_t)(ROW_META + r) * INW + C_K + c]); out[O_MV + i] = bf2f(PROJ[(size_t)(ROW_META + r) * INW + C_V + c]); }
        for (int i = gt; i < 128 * 256; i += NT) { const int r = i >> 8, c = i & 255; out[O_WK + i] = bf2f(PROJ[(size_t)(TX - 128 + r) * INW + C_K + c]); out[O_WV + i] = bf2f(PROJ[(size_t)(TX - 128 + r) * INW + C_V + c]); }
        for (int i = gt; i < 3 * 1024; i += NT) { const int r = i >> 10, c = i & 1023; out[O_CONV + i] = bf2f(PROJ[(size_t)(TX - 3 + r) * INW + C_XB + c]); }
        for (int i = gt; i < 128 * 3 * 1024; i += NT) { const int b = i / 3072, r = (i / 1024) % 3, c = i & 1023;
            out[O_CONVS + i] = (r < 2) ? ka->in[6][((size_t)b * 3 + r + 1) * LRUW + c] : bf2f(PROJ[(size_t)(ROW_SAMP + b) * INW + C_XB + c]); }
        for (int i = gt; i < 128 * 128; i += NT) { const int row = ROW_META + (i >> 7), c8 = (i & 127) * 8;
            *(u32x4*)(MIX + (size_t)row * 2048 + c8) = (u32x4){0u, 0u, 0u, 0u}; *(u32x4*)(MIX + (size_t)row * 2048 + 1024 + c8) = (u32x4){0u, 0u, 0u, 0u}; }
    }
    GRID_BAR(2);

    if (IN(3)) {
        const KArgs ka = KA();
        LruP LP{PROJ, Wg_t, ka->in[11], ka->in[12], ka->in[14], ka->in[16], ka->in[17], ka->in[6], ka->in[7], AGG, MIX + 1024, out + O_HS, out + O_H};
        lru_run<1>(lds, LP, bx & 7, bx >> 3);
    }
    GRID_BAR(3);

    if (IN(4)) {
        const KArgs ka = KA();
        for (int t = bx; t < 64; t += G)
            skinny_task(lds, MIX + (size_t)ROW_SAMP * DM, DM, Wmix_t, DM, 32 * t, 0, DM, 2,
                [&](int row, int col, float v) { const bf16* gp = PROJ + (size_t)(ROW_SAMP + row) * INW + col;
                    return v * (1.0f + __builtin_amdgcn_exp2f(-LOG2E * bf2f(gp[C_GL]))) * __builtin_amdgcn_rcpf(1.0f + __builtin_amdgcn_exp2f(-LOG2E * bf2f(gp[C_GA]))); },
                [&](int row, int col, float v) { const float o = sigm(bf2f(PROJ[(size_t)(ROW_SAMP + row) * INW + C_GL + col])) * v;
                    MERGED[(size_t)(ROW_SAMP + row) * DM + col] = (bf16)(pk2(o, 0.f) & 0xffffu); });
        pg8::Gemm g{MIX, Wmix_t, TX, DM, DM}; pg8::StaticOrder S; S.init(TX, DM, G, bx);
        pg8::EpiMergeFused E{PROJ + C_GA, PROJ + C_GL, INW, MERGED};
        pg8::gemm_phase<pg8::EpiMergeFused, pg8::StaticOrder, true, true>(lds, g, S, E);
    }
    GRID_BAR(4);

    if (IN(5)) {
        const KArgs ka = KA();
        for (int t = bx; t < 64; t += G)
            skinny_task(lds, MERGED + (size_t)ROW_SAMP * DM, DM, Wo_t, DM, 32 * t, 0, DM, -1, [](int, int, float v) { return v; }, [&](int row, int col, float v) {
                const float h = XTAIL[(size_t)row * DM + col] + v;
                TAILF[(size_t)row * DM + col] = h; HB[(size_t)(ROW_SAMP + row) * DM + col] = (bf16)(pk2(h, 0.f) & 0xffffu);
                float q = h * h; q += __shfl_xor(q, 1); q += __shfl_xor(q, 2); q += __shfl_xor(q, 4); q += __shfl_xor(q, 8);
                if ((threadIdx.x & 15) == 0) atomicAdd(SS + ROW_SAMP + row, q); });
        pg8::Gemm g{MERGED, Wo_t, TX, DM, DM}; pg8::StaticOrder S; S.init(TX, DM, G, bx);
        pg8::EpiResid E{x_prompt, HB, SS};
        pg8::gemm_phase<pg8::EpiResid, pg8::StaticOrder, true, true>(lds, g, S, E);
    }
    GRID_BAR(5);

    if (IN(6)) {
        const KArgs ka = KA();
        for (int t = bx; t < 256; t += G)
            skinny_task(lds, HB + (size_t)ROW_SAMP * DM, DM, Wup_t, DM, 32 * t, 0, DM, -1, [](int, int, float v) { return v; }, [&](int row, int col, float v) {
                const float a = fmaxf(v * __builtin_amdgcn_rsqf(SS[ROW_SAMP + row] * (1.0f / DM) + RMS_EPS), 0.f);
                UB[(size_t)(ROW_SAMP + row) * DFF + col] = (bf16)(pk2(a * a, 0.f) & 0xffffu); });
        pg8::Gemm g{HB, Wup_t, TX, DFF, DM}; pg8::StaticOrder S; S.init(TX, DFF, G, bx);
#if DUP_PHASE == 6 && defined(PROBE_NOSTORE)
        if (lo == 0) { pg8::EpiNull E0{}; pg8::gemm_phase<pg8::EpiNull, pg8::StaticOrder, true, true>(lds, g, S, E0); } else
#endif
        { pg8::EpiUp E{SS, UB};
        pg8::gemm_phase<pg8::EpiUp, pg8::StaticOrder, true, true>(lds, g, S, E); }
    }
    GRID_BAR(6);

    if (IN(7)) {
        const KArgs ka = KA();
        for (int t = bx; t < 256; t += G) { const int ksp = t >> 6;
            skinny_task(lds, UB + (size_t)ROW_SAMP * DFF, DFF, Wdn_t, DFF, 32 * (t & 63), 2048 * ksp, 2048, -1, [](int, int, float v) { return v; }, [&](int row, int col, float v) {
                PART[((size_t)ksp * 128 + row) * DM + col] = v; }); }
        pg8::Gemm g{UB, Wdn_t, TX, DM, DFF}; pg8::StaticOrder S; S.init(TX, DM, G, bx);
#if DUP_PHASE == 7
        if (lo == 0) { pg8::EpiProj E0{HB, DM, HB, DM}; pg8::gemm_phase<pg8::EpiProj, pg8::StaticOrder, true, true>(lds, g, S, E0); } else
#endif
        { pg8::EpiDown E{HB, out + O_Y};
        pg8::gemm_phase<pg8::EpiDown, pg8::StaticOrder, true, true>(lds, g, S, E); }
    }
    GRID_BAR(7);

    if (IN(8)) {
        const KArgs ka = KA();
        const float* gf = ka->in[25];
        for (int m = gw; m < TX + NSAMP; m += NGW) {
            const bool smp = (m >= TX);
            const float* src = smp ? TAILF + (size_t)(m - TX) * DM : out + O_Y + (size_t)m * DM;
            float* dst = smp ? out + O_YS + (size_t)(m - TX) * DM : out + O_Y + (size_t)m * DM;
            f32x4 v[8]; float s = 0.f;
#pragma unroll
            for (int j = 0; j < 8; ++j) { v[j] = *((const f32x4*)src + lane + 64 * j);
                if (smp) {
#pragma unroll
                    for (int ks = 0; ks < 4; ++ks) v[j] += *((const f32x4*)(PART + ((size_t)ks * 128 + (m - TX)) * DM) + lane + 64 * j); }
                s += (v[j].x * v[j].x + v[j].y * v[j].y) + (v[j].z * v[j].z + v[j].w * v[j].w); }
            const float r = __builtin_amdgcn_rsqf(wave_sum(s) * (1.0f / DM) + RMS_EPS);
#pragma unroll
            for (int j = 0; j < 8; ++j) { const f32x4 gg = *((const f32x4*)gf + lane + 64 * j); *((f32x4*)dst + lane + 64 * j) = v[j] * r * gg; }
        }
    }
#undef IN
#undef GRID_BAR
#undef G
#undef bx
#undef gw
#undef NGW
#undef ws
#undef out
#undef x_prompt
#undef x_sample
}

extern "C" void kernel_launch(void* const* d_in, const int* in_sizes, int n_in, void* d_out, int out_size, void* d_ws, size_t ws_size, hipStream_t stream) {
    static int grid = 0;
    if (grid == 0) {
        if (n_in != 26 || (size_t)out_size != O_END || ws_size < WS_END) { fprintf(stderr, "kernel_launch: unexpected shapes (n_in %d, out %d, ws %zu)\n", n_in, out_size, ws_size); grid = -1; return; }
        int dev = 0, cus = 0, per_cu = 0;
        if (hipGetDevice(&dev) != hipSuccess || hipDeviceGetAttribute(&cus, hipDeviceAttributeMultiprocessorCount, dev) != hipSuccess) { grid = -1; return; }
        if (hipFuncSetAttribute((const void*)griffin_fwd, hipFuncAttributeMaxDynamicSharedMemorySize, LDS_BYTES) != hipSuccess) { fprintf(stderr, "kernel_launch: hipFuncSetAttribute failed\n"); grid = -1; return; }
        if (hipOccupancyMaxActiveBlocksPerMultiprocessor(&per_cu, (const void*)griffin_fwd, NWAVES * 64, LDS_BYTES) != hipSuccess || per_cu < 1) { fprintf(stderr, "kernel_launch: occupancy query says %d\n", per_cu); (void)hipGetLastError(); grid = -1; return; }
        grid = cus;
        if (grid % 8 != 0 || grid > 256) { fprintf(stderr, "kernel_launch: unexpected CU count %d\n", cus); if (grid > 256) grid = 256; }
    }
    if (grid < 0) return;
    Args a{};
    for (int i = 0; i < 26; ++i) a.in[i] = (const float*)d_in[i];
    a.out = (float*)d_out; a.ws = (unsigned char*)d_ws;
    if (MK_N_LAUNCHES == 1) {
        const int ncut = (DUP_PHASE >= 0) ? 2 : 1;
        const int kd = DUP_PHASE % 100;
        for (int li = 0; li < ncut; ++li) {
            if (ncut == 1) { a.ph_lo = 0; a.ph_hi = N_PHASES; }
            else if (li == 0) { a.ph_lo = 0; a.ph_hi = kd + 1; }
            else { a.ph_lo = (DUP_PHASE >= 100) ? kd + 1 : kd; a.ph_hi = N_PHASES; }
            if (hipMemsetAsync((char*)d_ws + WS_CTL, 0, CTL_ZERO_BYTES, stream) != hipSuccess) { fprintf(stderr, "kernel_launch: hipMemsetAsync failed\n"); return; }
            if (li == 1 && DUP_PHASE == 5) (void)hipMemsetAsync((char*)d_ws + WS_SS, 0, (size_t)MROWS * 4, stream);
            void* kargs[] = {&a};
#if defined(PLAIN_LAUNCH)
            (void)kargs; hipLaunchKernelGGL(griffin_fwd, dim3(grid), dim3(NWAVES * 64), LDS_BYTES, stream, a);
#else
            hipError_t e = hipLaunchCooperativeKernel((const void*)griffin_fwd, dim3(grid), dim3(NWAVES * 64), kargs, LDS_BYTES, stream);
            if (e != hipSuccess) fprintf(stderr, "kernel_launch: cooperative launch failed: %s (grid %d)\n", hipGetErrorString(e), grid);
#endif
        }
    } else {
        for (int p = 0; p < N_PHASES; ++p) { a.ph_lo = p; a.ph_hi = p + 1; hipLaunchKernelGGL(griffin_fwd, dim3(grid), dim3(NWAVES * 64), LDS_BYTES, stream, a); }
    }
}
```
